# Optimizing an MI355X kernel written in HIP

```python
import math
import jax, jax.numpy as jnp
from jax import lax
import numpy as np

D_MODEL = 2048
BATCH = 16
SEQ = 2048
DEPTH = 1

ATTN_HEADS = 16
ATTN_KV_HEADS = 4
ATTN_HEAD_DIM = 64
ATTN_GROUP = ATTN_HEADS // ATTN_KV_HEADS
WINDOW = 128
ATTN_BLOCK = WINDOW
ATTN_WIDTH = ATTN_HEADS * ATTN_HEAD_DIM
KV_WIDTH = ATTN_KV_HEADS * ATTN_HEAD_DIM
HGRN_HEADS = 8
HGRN_KEY_DIM = 128
HGRN_VALUE_DIM = 128
HGRN_WIDTH = HGRN_HEADS * HGRN_VALUE_DIM
HGRN_CHUNK = 64
REL_BUCKETS = 32
REL_MAX_DIST = 128
NORM_EPS = 1e-6
IN_WIDTHS = (ATTN_WIDTH, KV_WIDTH, KV_WIDTH, ATTN_WIDTH,
             HGRN_HEADS * HGRN_KEY_DIM, HGRN_HEADS * HGRN_KEY_DIM, HGRN_WIDTH, HGRN_WIDTH,
             D_MODEL, D_MODEL)
IN_PROJ_WIDTH = 10752

kernel_name = 'hybrid_swa_sinks_hgrn2_gated_merge'


def rms_norm(x, gain):
    xf = x.astype(jnp.float32)
    y = xf * lax.rsqrt(jnp.mean(xf * xf, axis=-1, keepdims=True) + NORM_EPS)
    return (y * gain.astype(jnp.float32)).astype(x.dtype)


def t5_bucket(dist):
    max_exact = REL_BUCKETS // 2
    d = jnp.maximum(dist, 0)
    df = jnp.maximum(d, 1).astype(jnp.float32)
    large = max_exact + (jnp.log(df / max_exact) / math.log(REL_MAX_DIST / max_exact)
                         * (REL_BUCKETS - max_exact)).astype(jnp.int32)
    large = jnp.minimum(large, REL_BUCKETS - 1)
    return jnp.where(d < max_exact, d, large)


def sliding_window_attention(q, k, v, sinks, rel_bias):
    B, S, _ = q.shape
    nb = S // ATTN_BLOCK
    qb = q.astype(jnp.float32).reshape(B, nb, ATTN_BLOCK, ATTN_KV_HEADS, ATTN_GROUP, ATTN_HEAD_DIM)

    def windows(t):
        t = t.astype(jnp.float32).reshape(B, S, ATTN_KV_HEADS, ATTN_HEAD_DIM)
        t = jnp.pad(t, ((0, 0), (ATTN_BLOCK, 0), (0, 0), (0, 0)))
        t = t.reshape(B, nb + 1, ATTN_BLOCK, ATTN_KV_HEADS, ATTN_HEAD_DIM)
        return jnp.concatenate([t[:, :-1], t[:, 1:]], axis=2)

    kw, vw = windows(k), windows(v)
    scores = jnp.einsum('bnqhgd,bnshd->bhgnqs', qb, kw) * (ATTN_HEAD_DIM ** -0.5)
    qi = jnp.arange(ATTN_BLOCK)[:, None]
    si = jnp.arange(2 * ATTN_BLOCK)[None, :]
    dist = qi + ATTN_BLOCK - si
    band = (dist >= 0) & (dist < WINDOW)
    key_pos = jnp.arange(nb)[:, None] * ATTN_BLOCK - ATTN_BLOCK + jnp.arange(2 * ATTN_BLOCK)[None, :]
    mask = band[None] & (key_pos >= 0)[:, None, :]
    bias = rel_bias[t5_bucket(dist)].astype(jnp.float32)
    bias = jnp.transpose(bias, (2, 0, 1)).reshape(ATTN_KV_HEADS, ATTN_GROUP, 1, ATTN_BLOCK, 2 * ATTN_BLOCK)
    scores = jnp.where(mask, scores + bias, -jnp.inf)
    sink = jnp.broadcast_to(sinks.astype(jnp.float32).reshape(ATTN_KV_HEADS, ATTN_GROUP, 1, 1, 1),
                            scores.shape[:-1] + (1,))
    probs = jax.nn.softmax(jnp.concatenate([scores, sink], axis=-1), axis=-1)[..., :-1]
    out = jnp.einsum('bhgnqs,bnshd->bnqhgd', probs, vw)
    return out.reshape(B, S, ATTN_WIDTH)


def hgrn2_recurrence(q, f_pre, i, lb):
    B, S, _ = q.shape
    nc = S // HGRN_CHUNK

    def chunks(t):
        return t.reshape(B, nc, HGRN_CHUNK, HGRN_HEADS, -1).transpose(1, 0, 3, 2, 4)

    lbf = lb.astype(jnp.float32)
    f = lbf + (1.0 - lbf) * jax.nn.sigmoid(f_pre.astype(jnp.float32))
    qc = chunks(jax.nn.silu(q.astype(jnp.float32)))
    kc = chunks(1.0 - f)
    vc = chunks(i.astype(jnp.float32))
    gc = jnp.cumsum(chunks(jnp.log(f)), axis=3)
    causal = jnp.tril(jnp.ones((HGRN_CHUNK, HGRN_CHUNK), dtype=bool))

    def step(state, inp):
        qt, kt, vt, gt = inp
        inter = jnp.einsum('bhcd,bhde->bhce', qt * jnp.exp(gt), state)
        diff = gt[:, :, :, None, :] - gt[:, :, None, :, :]
        decay = jnp.exp(jnp.where(causal[:, :, None], diff, -jnp.inf))
        attn = jnp.einsum('bhtd,bhsd,bhtsd->bhts', qt, kt, decay)
        intra = jnp.einsum('bhts,bhse->bhte', attn, vt)
        g_last = gt[:, :, -1]
        k_dec = kt * jnp.exp(g_last[:, :, None, :] - gt)
        new_state = jnp.exp(g_last)[..., None] * state + jnp.einsum('bhsd,bhse->bhde', k_dec, vt)
        return new_state, inter + intra

    s0 = jnp.zeros((B, HGRN_HEADS, HGRN_KEY_DIM, HGRN_VALUE_DIM), jnp.float32)
    _, o = lax.scan(step, s0, (qc, kc, vc, gc))
    return o.transpose(1, 0, 3, 2, 4).reshape(B, S, HGRN_HEADS, HGRN_VALUE_DIM)


def setup_inputs(seed: int = 0) -> dict:
    key = jax.random.key(seed)
    ks = jax.random.split(key, 12)
    f32 = jnp.float32
    return {
        'x': jax.random.normal(ks[0], (BATCH, SEQ, D_MODEL), f32),
        'norm_pre': 1.0 + 0.1 * jax.random.normal(ks[1], (DEPTH, D_MODEL), f32),
        'w_in': jax.random.normal(ks[2], (DEPTH, D_MODEL, IN_PROJ_WIDTH), f32) * D_MODEL ** -0.5,
        'rel_bias': 0.5 * jax.random.normal(ks[3], (REL_BUCKETS, ATTN_HEADS), f32),
        'attn_sinks': jax.random.normal(ks[4], (DEPTH, ATTN_HEADS), f32),
        'lb_logits': 0.5 * jax.random.normal(ks[5], (DEPTH + 1, HGRN_HEADS * HGRN_KEY_DIM), f32),
        'hgrn_norm': 1.0 + 0.1 * jax.random.normal(ks[6], (DEPTH, HGRN_HEADS, HGRN_VALUE_DIM), f32),
        'w_branch_attn': jax.random.normal(ks[7], (DEPTH, ATTN_WIDTH, D_MODEL), f32) * ATTN_WIDTH ** -0.5,
        'w_branch_hgrn': jax.random.normal(ks[8], (DEPTH, HGRN_WIDTH, D_MODEL), f32) * HGRN_WIDTH ** -0.5,
        'w_out': jax.random.normal(ks[9], (DEPTH, D_MODEL, D_MODEL), f32) * D_MODEL ** -0.5,
        'norm_post': 1.0 + 0.1 * jax.random.normal(ks[10], (DEPTH, D_MODEL), f32),
    }


def reference(x, norm_pre, w_in, rel_bias, attn_sinks, lb_logits, hgrn_norm,
              w_branch_attn, w_branch_hgrn, w_out, norm_post):
    split_points = [int(p) for p in np.cumsum(IN_WIDTHS)[:-1]]
    lower_bounds = jnp.cumsum(jax.nn.softmax(lb_logits.astype(jnp.float32), axis=0), axis=0)[:DEPTH]
    for layer in range(DEPTH):
        h = rms_norm(x, norm_pre[layer])
        proj = jnp.matmul(h, w_in[layer])
        aq, ak, av, ag, hq, hf, hi, hg, gate_a, gate_h = jnp.split(proj, split_points, axis=-1)
        ya = sliding_window_attention(aq, ak, av, attn_sinks[layer], rel_bias)
        ya = (ya * jax.nn.silu(ag.astype(jnp.float32))).astype(x.dtype)
        oh = rms_norm(hgrn2_recurrence(hq, hf, hi, lower_bounds[layer]), hgrn_norm[layer])
        yh = (oh.reshape(oh.shape[0], oh.shape[1], HGRN_WIDTH)
              * jax.nn.silu(hg.astype(jnp.float32))).astype(x.dtype)
        ua = jnp.matmul(ya, w_branch_attn[layer])
        uh = jnp.matmul(yh, w_branch_hgrn[layer])
        merged = jax.nn.sigmoid(gate_a) * ua + jax.nn.sigmoid(gate_h) * uh
        y = jnp.matmul(merged, w_out[layer])
        x = x + rms_norm(y, norm_post[layer]).astype(x.dtype)
    return x
```

```cpp
#include <hip/hip_runtime.h>
#include <cstdio>

#ifndef MK_N_LAUNCHES
#define MK_N_LAUNCHES 1
#endif

namespace pg8 {
#define PG8_LAS __attribute__((address_space(3)))
typedef unsigned short bf16_t;
typedef short bf16x8 __attribute__((ext_vector_type(8)));
typedef float f32x4 __attribute__((ext_vector_type(4)));
typedef unsigned u32x4 __attribute__((ext_vector_type(4)));
constexpr int BM = 256, BK = 64, HALF = 128, HTB = HALF * BK * 2, STAGE_BYTES = 8 * HTB, NXCD = 8, WGM = 8;

__host__ __device__ __forceinline__ int lds_byte(int r, int c) { const int st = (r >> 4) * 2 + (c >> 5), rr = r & 15, cc = c & 31, ob = rr * 64 + cc * 2; return st * 1024 + (ob ^ (((ob >> 9) & 1) << 5)); }
__host__ __device__ __forceinline__ void stage_rc(int b, int& R, int& C) { const int st = b / 1024, sb = b % 1024, swz = sb ^ (((sb >> 9) & 1) << 5); R = (st >> 1) * 16 + swz / 64; C = (st & 1) * 32 + (swz % 64) / 2; }
__host__ __device__ __forceinline__ int perm32(int rho) { const int n = rho >> 4, i = rho & 15; return 8 * (i >> 2) + 4 * n + (i & 3); }

struct Unit { int pm, pn, br; };
struct Gemm { const bf16_t* A; const bf16_t* Bt; int M, N, K, ld; };

struct StaticOrder {
    int nM, nN, nwg, G, c;
    __host__ __device__ void init(int M, int N, int G_, int c_) { nM = M / BM; nN = N / BM; nwg = nM * nN; G = G_; c = c_; }
    __host__ __device__ bool tile(int i, int& pm, int& pn) const {
        const long L = (long)i * G + c; if (L >= nwg) return false;
        int wgid = (int)L; { const int q = nwg / NXCD, r = nwg % NXCD, xcd = wgid % NXCD, off = wgid / NXCD; wgid = (xcd < r ? xcd * (q + 1) : r * (q + 1) + (xcd - r) * q) + off; }
        const int nig = WGM * nN, gid = wgid / nig, fm = gid * WGM, gsz = (nM - fm) < WGM ? (nM - fm) : WGM;
        pm = fm + ((wgid % nig) % gsz); pn = (wgid % nig) / gsz; return true;
    }
    __host__ __device__ bool next(int i, Unit& u) const { u.br = 0; return tile(i, u.pm, u.pn); }
    __device__ __forceinline__ bool keep(const Unit&) const { return false; }
};
struct BranchOrder : StaticOrder {
    __host__ __device__ bool next(int v, Unit& u) const { u.br = v & 1; return tile(v >> 1, u.pm, u.pn); }
    __device__ __forceinline__ bool keep(const Unit& u) const { return u.br == 0; }
};

typedef float f32x2_t __attribute__((ext_vector_type(2)));
typedef __bf16 bf16x2_t __attribute__((ext_vector_type(2)));
__device__ __forceinline__ unsigned cvt_pk_bf16(float lo, float hi) { f32x2_t v = {lo, hi}; bf16x2_t b = __builtin_convertvector(v, bf16x2_t); return __builtin_bit_cast(unsigned, b); }
__device__ __forceinline__ float bf_lo(unsigned w) { return __uint_as_float(w << 16); }
__device__ __forceinline__ float bf_hi(unsigned w) { return __uint_as_float(w & 0xffff0000u); }

struct EpiF32 {
    static constexpr bool PERM = false;
    float* C; int ldc;
    __device__ __forceinline__ void operator()(f32x4 (&acc)[2][2][4][2], const Unit& u, int wr, int wc, int fr, int fq) const {
        const int row0 = u.pm * BM + wr * 64 + fr, col0 = u.pn * BM + wc * 32 + 4 * fq;
#pragma unroll
        for (int ai = 0; ai < 2; ++ai)
#pragma unroll
            for (int m = 0; m < 4; ++m) { float* rowp = C + (size_t)(row0 + ai * HALF + m * 16) * ldc + col0;
#pragma unroll
                for (int bj = 0; bj < 2; ++bj)
#pragma unroll
                    for (int n = 0; n < 2; ++n) *(f32x4*)(rowp + bj * HALF + n * 16) = acc[ai][bj][m][n]; }
    }
};

template <class Epi, class Sched>
__device__ __forceinline__ void gemm_phase(PG8_LAS unsigned char* lds, const Gemm g, const Sched& S, const Epi& E) {
    const int tid = threadIdx.x, wid = __builtin_amdgcn_readfirstlane(tid >> 6), lane = tid & 63, wr = wid >> 2, wc = wid & 3, fr = lane & 15, fq = lane >> 4;
    const int K = g.K, nt = K / BK, ld = g.ld;
    unsigned voffA[2], voffB[2];
#pragma unroll
    for (int i = 0; i < 2; ++i) { int R, C; stage_rc(tid * 16 + i * 8192, R, C); const int Rb = Epi::PERM ? ((R & ~31) + perm32(R & 31)) : R;
        voffA[i] = (unsigned)(R * ld + C) * 2u; voffB[i] = (unsigned)(Rb * ld + C) * 2u; }
    const size_t kstep = (size_t)(BK * 2);
    const size_t hstep = (size_t)HALF * ld * 2;
    const size_t tstep = 2 * hstep;
    const size_t brstep = (size_t)K * 2;
    const unsigned ldsw = (unsigned)wid * 1024u;
    const int aoff = lds_byte(wr * 64 + fr, fq * 8), boff = lds_byte(wc * 32 + fr, fq * 8);
#define PG8_SA(b, h) (((b) * 2 + (h)) * HTB)
#define PG8_SB(b, h) ((4 + (b) * 2 + (h)) * HTB)
#define PG8_STAGE(bufoff, gbase, voff) do { _Pragma("unroll") for (int _i = 0; _i < 2; ++_i) \
        __builtin_amdgcn_global_load_lds((const unsigned*)((const char*)(gbase) + (voff)[_i]), (PG8_LAS unsigned*)(lds + (bufoff) + ldsw + _i * 8192), 16, 0, 0); } while (0)
#define PG8_LDA(dst, b, h) do { _Pragma("unroll") for (int m = 0; m < 4; ++m) _Pragma("unroll") for (int k = 0; k < 2; ++k) dst[m][k] = *(const PG8_LAS bf16x8*)(lds + PG8_SA(b, h) + aoff + m * 2048 + k * 1024); } while (0)
#define PG8_LDB(dst, b, h) do { _Pragma("unroll") for (int n = 0; n < 2; ++n) _Pragma("unroll") for (int k = 0; k < 2; ++k) dst[n][k] = *(const PG8_LAS bf16x8*)(lds + PG8_SB(b, h) + boff + n * 2048 + k * 1024); } while (0)
#define PG8_MMA(ai, bj, At, Bt) do { __builtin_amdgcn_s_setprio(1); _Pragma("unroll") for (int m = 0; m < 4; ++m) _Pragma("unroll") for (int n = 0; n < 2; ++n) _Pragma("unroll") for (int k = 0; k < 2; ++k) \
        acc[ai][bj][m][n] = __builtin_amdgcn_mfma_f32_16x16x32_bf16(Bt[n][k], At[m][k], acc[ai][bj][m][n], 0, 0, 0); __builtin_amdgcn_s_setprio(0); } while (0)
#define PG8_WAIT_V(n) asm volatile("s_waitcnt vmcnt(" #n ")" ::: "memory")
#define PG8_WAIT_L(n) asm volatile("s_waitcnt lgkmcnt(" #n ")" ::: "memory")
#define PG8_BAR __builtin_amdgcn_s_barrier()
#define PG8_SCHED __builtin_amdgcn_sched_barrier(0)
    Unit cur, nxt; int ui = 0;
    if (!S.next(0, cur)) return;
    f32x4 acc[2][2][4][2];
#pragma unroll
    for (int a = 0; a < 2; ++a)
#pragma unroll
        for (int b = 0; b < 2; ++b)
#pragma unroll
            for (int m = 0; m < 4; ++m)
#pragma unroll
                for (int n = 0; n < 2; ++n) acc[a][b][m][n] = (f32x4){0.f, 0.f, 0.f, 0.f};
    bf16x8 At[4][2], B0[2][2], B1[2][2];
    const char* cA = (const char*)g.A + (size_t)cur.pm * tstep + (size_t)cur.br * brstep; const char* cB = (const char*)g.Bt + (size_t)cur.pn * tstep + (size_t)cur.br * brstep;
    PG8_STAGE(PG8_SB(0, 0), cB, voffB); PG8_STAGE(PG8_SB(0, 1), cB + hstep, voffB); PG8_STAGE(PG8_SA(0, 0), cA, voffA); PG8_STAGE(PG8_SA(0, 1), cA + hstep, voffA);
    if (wr == 1) PG8_BAR;
    PG8_WAIT_V(2); PG8_BAR;
    PG8_STAGE(PG8_SB(1, 0), cB + kstep, voffB); PG8_STAGE(PG8_SA(1, 0), cA + kstep, voffA); PG8_STAGE(PG8_SB(1, 1), cB + hstep + kstep, voffB);
    PG8_WAIT_V(6); PG8_BAR;
    for (;;) {
        const bool has_next = S.next(ui + 1, nxt);
        const char* nA = has_next ? (const char*)g.A + (size_t)nxt.pm * tstep + (size_t)nxt.br * brstep : cA; const char* nB = has_next ? (const char*)g.Bt + (size_t)nxt.pn * tstep + (size_t)nxt.br * brstep : cB;
        for (int t = 0; t < nt; t += 2) {
            const bool last = (t == nt - 2);
            const char* a1 = cA + (size_t)(t + 1) * kstep;
            const char* a2 = last ? nA : cA + (size_t)(t + 2) * kstep; const char* b2 = last ? nB : cB + (size_t)(t + 2) * kstep;
            const char* a3 = a2 + kstep; const char* b3 = b2 + kstep;
            PG8_LDB(B0, 0, 0); PG8_LDB(B1, 0, 1); PG8_SCHED; PG8_LDA(At, 0, 0); PG8_STAGE(PG8_SA(1, 1), a1 + hstep, voffA);
            PG8_WAIT_V(8); PG8_WAIT_L(0); PG8_BAR; PG8_MMA(0, 0, At, B0); PG8_MMA(0, 1, At, B1); PG8_BAR; PG8_SCHED;
            PG8_LDA(At, 0, 1); PG8_STAGE(PG8_SB(0, 0), b2, voffB); PG8_STAGE(PG8_SB(0, 1), b2 + hstep, voffB); PG8_STAGE(PG8_SA(0, 0), a2, voffA);
            PG8_WAIT_V(8); PG8_WAIT_L(0); PG8_BAR; PG8_MMA(1, 0, At, B0); PG8_MMA(1, 1, At, B1); PG8_BAR; PG8_SCHED;
            PG8_LDB(B0, 1, 0); PG8_LDB(B1, 1, 1); PG8_SCHED; PG8_LDA(At, 1, 0); PG8_STAGE(PG8_SA(0, 1), a2 + hstep, voffA);
            PG8_WAIT_V(8); PG8_WAIT_L(0); PG8_BAR; PG8_MMA(0, 0, At, B0); PG8_MMA(0, 1, At, B1); PG8_BAR; PG8_SCHED;
            PG8_LDA(At, 1, 1); PG8_STAGE(PG8_SB(1, 0), b3, voffB); PG8_STAGE(PG8_SB(1, 1), b3 + hstep, voffB); PG8_STAGE(PG8_SA(1, 0), a3, voffA);
            PG8_WAIT_V(8); PG8_WAIT_L(0); PG8_BAR; PG8_MMA(1, 0, At, B0); PG8_MMA(1, 1, At, B1); PG8_BAR; PG8_SCHED;
        }
        if (wr == 0) PG8_BAR;
        E(acc, cur, wr, wc, fr, fq);
        if (!has_next) break;
        if (!S.keep(cur)) {
#pragma unroll
            for (int a = 0; a < 2; ++a)
#pragma unroll
                for (int b = 0; b < 2; ++b)
#pragma unroll
                    for (int m = 0; m < 4; ++m)
#pragma unroll
                        for (int n = 0; n < 2; ++n) acc[a][b][m][n] = (f32x4){0.f, 0.f, 0.f, 0.f};
        }
        cur = nxt; cA = nA; cB = nB; ++ui;
        if (wr == 1) PG8_BAR;
    }
    PG8_WAIT_V(0);
    PG8_BAR;
#undef PG8_SA
#undef PG8_SB
#undef PG8_STAGE
#undef PG8_LDA
#undef PG8_LDB
#undef PG8_MMA
#undef PG8_WAIT_V
#undef PG8_WAIT_L
#undef PG8_BAR
#undef PG8_SCHED
}
}

constexpr int NWAVES = 8;
constexpr int N_LAUNCHES = MK_N_LAUNCHES;
constexpr int PER_PHASE = 7;
constexpr int BATCH = 16, SEQ = 2048, D = 2048, M = BATCH * SEQ;
constexpr int NIN = 10752;
constexpr int AW = 1024, KVW = 256, HW = 1024;
constexpr float NORM_EPS = 1e-6f;
constexpr float LOG2E = 1.4426950408889634f;
constexpr float QSCALE = 0.125f * LOG2E;

constexpr size_t MiB = 1u << 20;
constexpr size_t WS_CTL = 0, CTL_ZERO_BYTES = 1 * MiB;
constexpr size_t WS_BIAS = 1 * MiB;
constexpr size_t WS_LB = 1 * MiB + 65536;
constexpr int LDH = 2048 + 64;
constexpr size_t WS_WIN = 864 * MiB;
constexpr size_t WS_W2 = 44 * MiB;
constexpr size_t WS_WO = 52 * MiB;
constexpr size_t WS_H = 60 * MiB;
constexpr size_t WS_Y12 = WS_H;
constexpr size_t WS_Q = 192 * MiB, WS_K = 256 * MiB, WS_V = 272 * MiB, WS_AG = 288 * MiB, WS_HQ = 352 * MiB, WS_LF = 416 * MiB, WS_HI = 480 * MiB, WS_HG = 544 * MiB;
constexpr size_t WS_SA = 608 * MiB, WS_SH = 736 * MiB;
constexpr size_t WS_ORAW = 864 * MiB;
constexpr size_t WS_MERGED = 192 * MiB;
constexpr size_t WS_YOUT = 352 * MiB;
constexpr size_t WS_END = 992 * MiB;
constexpr int CW_TMO = 0, CW_CODE = 1;
constexpr int CW_BAR = 4096;

constexpr int RING_OFF = 0, RING_BYTES = 131072;
constexpr int LDSCTL_OFF = RING_BYTES, MISC_OFF = LDSCTL_OFF + 320;
constexpr int LDS_BYTES = 147456;

#define GAS __attribute__((address_space(1)))
#define LAS __attribute__((address_space(3)))
typedef unsigned short bf16;
typedef unsigned v4u __attribute__((ext_vector_type(4)));
typedef float f32x4 __attribute__((ext_vector_type(4)));
typedef GAS unsigned gu32;
#define RLX_AGENT __ATOMIC_RELAXED, __HIP_MEMORY_SCOPE_AGENT
#define LDS_WAIT() asm volatile("s_waitcnt lgkmcnt(0)" ::: "memory")
#define VM_WAIT() asm volatile("s_waitcnt vmcnt(0)" ::: "memory")
__device__ __forceinline__ unsigned f2bf(float f) { unsigned u = __builtin_bit_cast(unsigned, f); return (u + 0x7fffu + ((u >> 16) & 1u)) >> 16; }
__device__ __forceinline__ unsigned pk2(float lo, float hi) { return f2bf(lo) | (f2bf(hi) << 16); }
__device__ __forceinline__ float bflo(unsigned w) { return __uint_as_float(w << 16); }
__device__ __forceinline__ float bfhi(unsigned w) { return __uint_as_float(w & 0xffff0000u); }
__device__ __forceinline__ float fsigmoid(float x) { return __builtin_amdgcn_rcpf(1.f + __expf(-x)); }

#define XB_TMO      128
#define XB_XCNT(j)  (256  + 64 * (j))
#define XB_XSUB(j)  (1280 + 64 * (j))
#define XB_XGEN(j)  (2304 + 64 * (j))
#define XB_TOP      3328
#define XB_TOPGEN   3392
#define XCD_BAR_WORDS 3456
#define XB_SPIN_CAP (1u << 23)
__device__ __forceinline__ unsigned xb_ld(unsigned* p)              { return __hip_atomic_load(p, __ATOMIC_RELAXED, __HIP_MEMORY_SCOPE_AGENT); }
__device__ __forceinline__ unsigned xb_add(unsigned* p, unsigned v) { return __hip_atomic_fetch_add(p, v, __ATOMIC_RELAXED, __HIP_MEMORY_SCOPE_AGENT); }
__device__ __forceinline__ unsigned xb_xcc_id() { return (unsigned)__builtin_amdgcn_s_getreg((3 << 11) | 20) & 0xFu; }
#define XB_SPIN(cond, bar) do { unsigned _sp = 0; while (cond) { __builtin_amdgcn_s_sleep(1); \
    if ((++_sp & 255u) == 0u) { if (xb_ld(&(bar)[XB_TMO])) break; if (_sp > XB_SPIN_CAP) { atomicAdd(&(bar)[XB_TMO], 1u); break; } } } } while (0)
struct XcdBarrier { unsigned* bar; unsigned x; volatile LAS unsigned* st; };
__device__ __forceinline__ XcdBarrier xcd_barrier_post(unsigned* bar, volatile LAS unsigned* st) {
    XcdBarrier b; b.bar = bar; b.x = xb_xcc_id(); b.st = st;
    if (threadIdx.x == 0) (void)xb_add(&bar[XB_XCNT(b.x)], 1u);
    return b;
}
__device__ __forceinline__ void xcd_barrier_complete(unsigned* bar, unsigned x, unsigned& nloc, unsigned& nx) {
    const unsigned G = gridDim.x * gridDim.y * gridDim.z;
    unsigned sum, cnt, mine, sp = 0u;
    for (;;) {
        sum = 0u; cnt = 0u; mine = 0u;
#pragma unroll
        for (unsigned j = 0; j < 16; ++j) { const unsigned c = xb_ld(&bar[XB_XCNT(j)]); sum += c; cnt += (c > 0u) ? 1u : 0u; mine = (j == x) ? c : mine; }
        if (sum == G) break;
        __builtin_amdgcn_s_sleep(1);
        if ((++sp & 255u) == 0u) { if (xb_ld(&bar[XB_TMO])) break; if (sp > XB_SPIN_CAP) { atomicAdd(&bar[XB_TMO], 1u); break; } }
    }
    nloc = mine > 0u ? mine : 1u; nx = cnt > 0u ? cnt : 1u;
}
__device__ __forceinline__ void xcd_barrier(const XcdBarrier& b) {
    asm volatile("s_waitcnt vmcnt(0)" ::: "memory");
    __syncthreads();
    if (threadIdx.x == 0) {
        unsigned* bar = b.bar;
        __builtin_amdgcn_s_waitcnt(0);
        unsigned nloc = b.st[0], nx = b.st[1];
        if (nloc == 0u) { xcd_barrier_complete(bar, b.x, nloc, nx); b.st[0] = nloc; b.st[1] = nx; }
        const unsigned old = xb_add(&bar[XB_XSUB(b.x)], 1u);
        const unsigned gen = old / nloc;
        if (old + 1u == (gen + 1u) * nloc) {
            __builtin_amdgcn_fence(__ATOMIC_RELEASE, "agent");
            asm volatile("s_waitcnt vmcnt(0)" ::: "memory");
            const unsigned og = xb_add(&bar[XB_TOP], 1u);
            const unsigned tg = og / nx;
            if (og + 1u == (tg + 1u) * nx) xb_add(&bar[XB_TOPGEN], 1u);
            else XB_SPIN(xb_ld(&bar[XB_TOPGEN]) == tg, bar);
            __builtin_amdgcn_fence(__ATOMIC_ACQUIRE, "agent");
            xb_add(&bar[XB_XGEN(b.x)], 1u);
            asm volatile("s_waitcnt vmcnt(0)" ::: "memory");
        } else {
            XB_SPIN(xb_ld(&bar[XB_XGEN(b.x)]) == gen, bar);
            __builtin_amdgcn_fence(__ATOMIC_ACQUIRE, "agent");
            asm volatile("s_waitcnt vmcnt(0)" ::: "memory");
        }
    }
    __syncthreads();
}

struct Frame {
    LAS unsigned char* lds;
    volatile LAS unsigned* MISC;
    gu32* ctl;
    int tid, lane, wave;
    int vcu, G;
    const float *x, *norm_pre, *w_in, *rel_bias, *sinks, *lb_logits, *hgrn_norm, *w_a, *w_h, *w_out, *norm_post;
    float* out;
    unsigned char* ws;
};
__device__ __forceinline__ float wave_sum(float v) {
#pragma unroll
    for (int o = 1; o < 64; o <<= 1) v += __shfl_xor(v, o);
    return v;
}

__device__ __forceinline__ void p0_transpose_item(const float* W, int K, int N, bf16* WT, int ldw, int koff, LAS float* scr, int item, int lane) {
    const int nblk = N / 32, kb = item / nblk, nb = item % nblk, k0 = 64 * kb, n0 = 32 * nb;
#pragma unroll 8
    for (int i = 0; i < 32; ++i) { const int kk = 2 * i + (lane >> 5); scr[kk * 33 + (lane & 31)] = W[(size_t)(k0 + kk) * N + n0 + (lane & 31)]; }
    LDS_WAIT(); asm volatile("" ::: "memory");
    const int c = lane & 7;
#pragma unroll
    for (int j = 0; j < 4; ++j) { const int n = (lane >> 3) + 8 * j; const LAS float* s = scr + (8 * c) * 33 + n;
        v4u o; o.x = pk2(s[0 * 33], s[1 * 33]); o.y = pk2(s[2 * 33], s[3 * 33]); o.z = pk2(s[4 * 33], s[5 * 33]); o.w = pk2(s[6 * 33], s[7 * 33]);
        *(GAS v4u*)(WT + (size_t)(n0 + n) * ldw + koff + k0 + 8 * c) = o; }
    LDS_WAIT(); asm volatile("" ::: "memory");
}
__device__ __forceinline__ void rms_row_to_bf16(int lane, const float* xrow, const float* gain, bf16* orow) {
    const GAS f32x4* xr = (const GAS f32x4*)xrow + lane;
    const GAS f32x4* gr = (const GAS f32x4*)gain + lane;
    f32x4 v[8]; float s = 0.f;
#pragma unroll
    for (int j = 0; j < 8; ++j) { v[j] = xr[64 * j]; s += (v[j].x * v[j].x + v[j].y * v[j].y) + (v[j].z * v[j].z + v[j].w * v[j].w); }
    const float rstd = 1.f / sqrtf(wave_sum(s) * (1.f / D) + NORM_EPS);
    GAS unsigned long long* o8 = (GAS unsigned long long*)orow + lane;
#pragma unroll
    for (int j = 0; j < 8; ++j) { const f32x4 g = gr[64 * j];
        o8[64 * j] = (unsigned long long)pk2(v[j].x * rstd * g.x, v[j].y * rstd * g.y) | ((unsigned long long)pk2(v[j].z * rstd * g.z, v[j].w * rstd * g.w) << 32); }
}
__device__ __forceinline__ int t5_bucket(int d) {
    if (d < 16) return d;
    int b = 16 + (int)(logf((float)d * (1.f / 16.f)) * (16.f / 2.0794415416798357f));
    return b < 31 ? b : 31;
}
__device__ __forceinline__ void p0_prologue(Frame& F) {
    LAS float* scr = (LAS float*)(F.lds + RING_OFF + F.wave * 16384);
    const int gw = F.vcu * NWAVES + F.wave, NGW = F.G * NWAVES;
    constexpr int I_IN = (D / 64) * (NIN / 32), I_A = (AW / 64) * (D / 32), I_H = (HW / 64) * (D / 32), I_O = (D / 64) * (D / 32);
    constexpr int NITEMS = I_IN + I_A + I_H + I_O;
    bf16* WIN = (bf16*)(F.ws + WS_WIN); bf16* W2 = (bf16*)(F.ws + WS_W2); bf16* WO = (bf16*)(F.ws + WS_WO);
    for (int it = gw; it < NITEMS; it += NGW) {
        int r = it;
        if (r < I_IN) { p0_transpose_item(F.w_in, D, NIN, WIN, LDH, 0, scr, r, F.lane); continue; } r -= I_IN;
        if (r < I_A) { p0_transpose_item(F.w_a, AW, D, W2, 2048, 0, scr, r, F.lane); continue; } r -= I_A;
        if (r < I_H) { p0_transpose_item(F.w_h, HW, D, W2, 2048, 1024, scr, r, F.lane); continue; } r -= I_H;
        p0_transpose_item(F.w_out, D, D, WO, D, 0, scr, r, F.lane);
    }
    bf16* H = (bf16*)(F.ws + WS_H);
    for (int m = gw; m < M; m += NGW) rms_row_to_bf16(F.lane, F.x + (size_t)m * D, F.norm_pre, H + (size_t)m * LDH);
    if (blockIdx.x == 0) {
        float* bt = (float*)(F.ws + WS_BIAS); float* lb = (float*)(F.ws + WS_LB);
        for (int i = F.tid; i < 16 * 128; i += NWAVES * 64) { const int h = i >> 7, d = i & 127; bt[i] = F.rel_bias[t5_bucket(d) * 16 + h] * LOG2E; }
        for (int i = F.tid; i < 1024; i += NWAVES * 64) { const float l0 = F.lb_logits[i], l1 = F.lb_logits[1024 + i]; lb[i] = 1.f / (1.f + expf(l1 - l0)); }
    }
}

template <int MODE> __device__ __forceinline__ float proj_act(float x, float lb) {
    if (MODE == 1) return x * fsigmoid(x);
    if (MODE == 2) return fsigmoid(x);
    if (MODE == 3) return __logf(lb + (1.f - lb) * fsigmoid(x));
    return x;
}
struct EpiProj {
    static constexpr bool PERM = true;
    unsigned char* ws;
    template <int MODE> __device__ __forceinline__ void store(pg8::f32x4 (&acc)[2][2][4][2], bf16* base, int ldc, int row0, int col0, float scale, const float* lbp) const {
        using pg8::f32x4; using pg8::u32x4;
        f32x4 lbv[2][2];
#pragma unroll
        for (int bj = 0; bj < 2; ++bj)
#pragma unroll
            for (int n = 0; n < 2; ++n) lbv[bj][n] = (MODE == 3) ? *(const f32x4*)(lbp + col0 + bj * 128 + 4 * n) : (f32x4){0.f, 0.f, 0.f, 0.f};
#pragma unroll
        for (int ai = 0; ai < 2; ++ai)
#pragma unroll
            for (int m = 0; m < 4; ++m) { bf16* rowp = base + (size_t)(row0 + ai * 128 + m * 16) * ldc + col0;
#pragma unroll
                for (int bj = 0; bj < 2; ++bj) { f32x4 v0 = acc[ai][bj][m][0], v1 = acc[ai][bj][m][1];
#pragma unroll
                    for (int j = 0; j < 4; ++j) { v0[j] = proj_act<MODE>(v0[j], lbv[bj][0][j]) * scale; v1[j] = proj_act<MODE>(v1[j], lbv[bj][1][j]) * scale; }
                    u32x4 w; w.x = pg8::cvt_pk_bf16(v0[0], v0[1]); w.y = pg8::cvt_pk_bf16(v0[2], v0[3]); w.z = pg8::cvt_pk_bf16(v1[0], v1[1]); w.w = pg8::cvt_pk_bf16(v1[2], v1[3]);
                    *(u32x4*)(rowp + bj * 128) = w; } }
    }
    __device__ __forceinline__ void operator()(pg8::f32x4 (&acc)[2][2][4][2], const pg8::Unit& u, int wr, int wc, int fr, int fq) const {
        const int pn = u.pn, row0 = u.pm * 256 + wr * 64 + fr, cw = wc * 32 + 8 * fq;
        const float* lbp = (const float*)(ws + WS_LB);
        if (pn < 4)       store<0>(acc, (bf16*)(ws + WS_Q), 1024, row0, (pn - 0) * 256 + cw, QSCALE, lbp);
        else if (pn == 4) store<0>(acc, (bf16*)(ws + WS_K), 256, row0, cw, 1.f, lbp);
        else if (pn == 5) store<0>(acc, (bf16*)(ws + WS_V), 256, row0, cw, 1.f, lbp);
        else if (pn < 10) store<1>(acc, (bf16*)(ws + WS_AG), 1024, row0, (pn - 6) * 256 + cw, 1.f, lbp);
        else if (pn < 14) store<1>(acc, (bf16*)(ws + WS_HQ), 1024, row0, (pn - 10) * 256 + cw, 1.f, lbp);
        else if (pn < 18) store<3>(acc, (bf16*)(ws + WS_LF), 1024, row0, (pn - 14) * 256 + cw, 1.f, lbp);
        else if (pn < 22) store<0>(acc, (bf16*)(ws + WS_HI), 1024, row0, (pn - 18) * 256 + cw, 1.f, lbp);
        else if (pn < 26) store<1>(acc, (bf16*)(ws + WS_HG), 1024, row0, (pn - 22) * 256 + cw, 1.f, lbp);
        else if (pn < 34) store<2>(acc, (bf16*)(ws + WS_SA), 2048, row0, (pn - 26) * 256 + cw, 1.f, lbp);
        else              store<2>(acc, (bf16*)(ws + WS_SH), 2048, row0, (pn - 34) * 256 + cw, 1.f, lbp);
    }
};

struct EpiMerge {
    static constexpr bool PERM = true;
    unsigned char* ws;
    __device__ __forceinline__ void operator()(pg8::f32x4 (&acc)[2][2][4][2], const pg8::Unit& u, int wr, int wc, int fr, int fq) const {
        using pg8::f32x4; using pg8::u32x4;
        const int row0 = u.pm * 256 + wr * 64 + fr, col0 = u.pn * 256 + wc * 32 + 8 * fq;
        const bf16* SA = (const bf16*)(ws + WS_SA); const bf16* SH = (const bf16*)(ws + WS_SH); bf16* MG = (bf16*)(ws + WS_MERGED);
#pragma unroll
        for (int ai = 0; ai < 2; ++ai)
#pragma unroll
            for (int m = 0; m < 4; ++m) { const size_t ro = (size_t)(row0 + ai * 128 + m * 16) * 2048 + col0;
#pragma unroll
                for (int bj = 0; bj < 2; ++bj) {
                    const u32x4 h = *(const u32x4*)(SH + ro + bj * 128);
                    const float h0 = bflo(h.x), h1 = bfhi(h.x), h2 = bflo(h.y), h3 = bfhi(h.y), h4 = bflo(h.z), h5 = bfhi(h.z), h6 = bflo(h.w), h7 = bfhi(h.w);
                    f32x4& v0 = acc[ai][bj][m][0]; f32x4& v1 = acc[ai][bj][m][1];
                    if (u.br == 0) {
                        const u32x4 a = *(const u32x4*)(SA + ro + bj * 128);
                        v0[0] *= bflo(a.x) / h0; v0[1] *= bfhi(a.x) / h1; v0[2] *= bflo(a.y) / h2; v0[3] *= bfhi(a.y) / h3;
                        v1[0] *= bflo(a.z) / h4; v1[1] *= bfhi(a.z) / h5; v1[2] *= bflo(a.w) / h6; v1[3] *= bfhi(a.w) / h7;
                    } else {
                        u32x4 w; w.x = pg8::cvt_pk_bf16(v0[0] * h0, v0[1] * h1); w.y = pg8::cvt_pk_bf16(v0[2] * h2, v0[3] * h3);
                        w.z = pg8::cvt_pk_bf16(v1[0] * h4, v1[1] * h5); w.w = pg8::cvt_pk_bf16(v1[2] * h6, v1[3] * h7);
                        *(u32x4*)(MG + ro + bj * 128) = w;
                    } } }
    }
};

__device__ __forceinline__ void attn_naive(Frame& F) {
    const bf16* Q = (const bf16*)(F.ws + WS_Q); const bf16* Kb = (const bf16*)(F.ws + WS_K); const bf16* Vb = (const bf16*)(F.ws + WS_V);
    const bf16* AG = (const bf16*)(F.ws + WS_AG); bf16* Y = (bf16*)(F.ws + WS_Y12);
    const float* bt = (const float*)(F.ws + WS_BIAS);
    const int nth = F.G * NWAVES * 64;
    for (int item = blockIdx.x * (NWAVES * 64) + F.tid; item < M * 16; item += nth) {
        const int tok = item >> 4, h = item & 15, kvh = h >> 2, t = tok & (SEQ - 1);
        float q[64], o[64];
        { const v4u* qp = (const v4u*)(Q + (size_t)tok * 1024 + h * 64);
#pragma unroll
          for (int c = 0; c < 8; ++c) { const v4u w = qp[c]; q[8 * c + 0] = bflo(w.x); q[8 * c + 1] = bfhi(w.x); q[8 * c + 2] = bflo(w.y); q[8 * c + 3] = bfhi(w.y); q[8 * c + 4] = bflo(w.z); q[8 * c + 5] = bfhi(w.z); q[8 * c + 6] = bflo(w.w); q[8 * c + 7] = bfhi(w.w); } }
#pragma unroll
        for (int d = 0; d < 64; ++d) o[d] = 0.f;
        float mx = F.sinks[h] * LOG2E, l = 1.f;
        const int nk = t < 127 ? t : 127;
        for (int dist = 0; dist <= nk; ++dist) {
            const size_t s = (size_t)(tok - dist);
            const v4u* kp = (const v4u*)(Kb + s * 256 + kvh * 64);
            float sc = 0.f;
#pragma unroll
            for (int c = 0; c < 8; ++c) { const v4u w = kp[c];
                sc += q[8 * c + 0] * bflo(w.x) + q[8 * c + 1] * bfhi(w.x) + q[8 * c + 2] * bflo(w.y) + q[8 * c + 3] * bfhi(w.y) + q[8 * c + 4] * bflo(w.z) + q[8 * c + 5] * bfhi(w.z) + q[8 * c + 6] * bflo(w.w) + q[8 * c + 7] * bfhi(w.w); }
            sc += bt[h * 128 + dist];
            const float mn = fmaxf(mx, sc), a = exp2f(mx - mn), p = exp2f(sc - mn);
            l = l * a + p; mx = mn;
            const v4u* vp = (const v4u*)(Vb + s * 256 + kvh * 64);
#pragma unroll
            for (int c = 0; c < 8; ++c) { const v4u w = vp[c];
                o[8 * c + 0] = o[8 * c + 0] * a + p * bflo(w.x); o[8 * c + 1] = o[8 * c + 1] * a + p * bfhi(w.x); o[8 * c + 2] = o[8 * c + 2] * a + p * bflo(w.y); o[8 * c + 3] = o[8 * c + 3] * a + p * bfhi(w.y);
                o[8 * c + 4] = o[8 * c + 4] * a + p * bflo(w.z); o[8 * c + 5] = o[8 * c + 5] * a + p * bfhi(w.z); o[8 * c + 6] = o[8 * c + 6] * a + p * bflo(w.w); o[8 * c + 7] = o[8 * c + 7] * a + p * bfhi(w.w); }
        }
        const float inv = 1.f / l;
        const v4u* gp = (const v4u*)(AG + (size_t)tok * 1024 + h * 64);
        v4u* yp = (v4u*)(Y + (size_t)tok * 2048 + h * 64);
#pragma unroll
        for (int c = 0; c < 8; ++c) { const v4u g = gp[c]; v4u w;
            w.x = pk2(o[8 * c + 0] * inv * bflo(g.x), o[8 * c + 1] * inv * bfhi(g.x)); w.y = pk2(o[8 * c + 2] * inv * bflo(g.y), o[8 * c + 3] * inv * bfhi(g.y));
            w.z = pk2(o[8 * c + 4] * inv * bflo(g.z), o[8 * c + 5] * inv * bfhi(g.z)); w.w = pk2(o[8 * c + 6] * inv * bflo(g.w), o[8 * c + 7] * inv * bfhi(g.w));
            yp[c] = w; }
    }
}


namespace att {
typedef short bf16x8 __attribute__((ext_vector_type(8)));
typedef short s16x4 __attribute__((ext_vector_type(4)));
typedef float f32x16 __attribute__((ext_vector_type(16)));
constexpr int L_K = 0, L_VT = 32768, VROWB = 520, L_BIAS = L_VT + 64 * VROWB, L_END = L_BIAS + 2048;
constexpr int NUNITS = BATCH * 16 * 4;
#define ATT_MFMA(a, b, c) __builtin_amdgcn_mfma_f32_32x32x16_bf16((a), (b), (c), 0, 0, 0)
__device__ __forceinline__ void decode(int unit, int& b, int& nb, int& kvh) { b = unit >> 6; nb = (unit >> 2) & 15; kvh = unit & 3; }
__device__ __forceinline__ void load_regs(Frame& F, int unit, v4u (&kr)[4], v4u (&vr)[4], float& bias) {
    int b, nb, kvh; decode(unit, b, nb, kvh);
    const bf16* Kb = (const bf16*)(F.ws + WS_K); const bf16* Vb = (const bf16*)(F.ws + WS_V);
    const int tok0 = b * SEQ + nb * 128;
#pragma unroll
    for (int i = 0; i < 4; ++i) { const int p = F.tid + 512 * i, key = p >> 3, chunk = p & 7; int row = tok0 - 128 + key; if (nb == 0 && key < 128) row = tok0;
        kr[i] = *(const v4u*)(Kb + (size_t)row * 256 + kvh * 64 + chunk * 8); }
#pragma unroll
    for (int i = 0; i < 2; ++i) { const int pp = F.tid + 512 * i, kp = pp & 127, chunk = pp >> 7; int row = tok0 - 128 + 2 * kp, row1 = row + 1; if (nb == 0 && kp < 64) { row = tok0; row1 = tok0; }
        vr[2 * i] = *(const v4u*)(Vb + (size_t)row * 256 + kvh * 64 + chunk * 8); vr[2 * i + 1] = *(const v4u*)(Vb + (size_t)row1 * 256 + kvh * 64 + chunk * 8); }
    bias = ((const float*)(F.ws + WS_BIAS))[(kvh * 4 + (F.tid >> 7)) * 128 + (F.tid & 127)];
}
__device__ __forceinline__ void write_lds(Frame& F, const v4u (&kr)[4], const v4u (&vr)[4], float bias) {
#pragma unroll
    for (int i = 0; i < 4; ++i) { const int p = F.tid + 512 * i, key = p >> 3, chunk = p & 7;
        *(LAS v4u*)(F.lds + L_K + key * 128 + ((chunk ^ ((key >> 1) & 7)) << 4)) = kr[i]; }
#pragma unroll
    for (int i = 0; i < 2; ++i) { const int pp = F.tid + 512 * i, kp = pp & 127, chunk = pp >> 7; const v4u a = vr[2 * i], c = vr[2 * i + 1];
        LAS unsigned char* base = F.lds + L_VT + (chunk * 8) * VROWB + kp * 4;
        *(LAS unsigned*)(base + 0 * VROWB) = (a.x & 0xffffu) | (c.x << 16);  *(LAS unsigned*)(base + 1 * VROWB) = (a.x >> 16) | (c.x & 0xffff0000u);
        *(LAS unsigned*)(base + 2 * VROWB) = (a.y & 0xffffu) | (c.y << 16);  *(LAS unsigned*)(base + 3 * VROWB) = (a.y >> 16) | (c.y & 0xffff0000u);
        *(LAS unsigned*)(base + 4 * VROWB) = (a.z & 0xffffu) | (c.z << 16);  *(LAS unsigned*)(base + 5 * VROWB) = (a.z >> 16) | (c.z & 0xffff0000u);
        *(LAS unsigned*)(base + 6 * VROWB) = (a.w & 0xffffu) | (c.w << 16);  *(LAS unsigned*)(base + 7 * VROWB) = (a.w >> 16) | (c.w & 0xffff0000u); }
    *(LAS float*)(F.lds + L_BIAS + F.tid * 4) = bias;
}
__device__ __forceinline__ void compute(Frame& F, int unit) {
    int b, nb, kvh; decode(unit, b, nb, kvh);
    const bf16* Q = (const bf16*)(F.ws + WS_Q); const bf16* AG = (const bf16*)(F.ws + WS_AG); bf16* Y = (bf16*)(F.ws + WS_Y12);
    const int g = F.wave >> 1, qh = F.wave & 1, r = F.lane & 31, h = F.lane >> 5, hq = kvh * 4 + g;
    const int tok0 = b * SEQ + nb * 128;
    const float sinkv = F.sinks[hq] * LOG2E;
    const LAS float* tab = (const LAS float*)(F.lds + L_BIAS) + g * 128;
    const int dl = r - 4 * h;
    for (int sb = 0; sb < 2; ++sb) {
        const int j = 2 * qh + sb; const size_t tok = (size_t)(tok0 + 32 * j + r);
        bf16x8 Qf[4];
#pragma unroll
        for (int s = 0; s < 4; ++s) Qf[s] = *(const bf16x8*)(Q + tok * 1024 + hq * 64 + 16 * s + 8 * h);
        f32x16 S[5];
#pragma unroll
        for (int c = 0; c < 5; ++c) { const int key = 32 * (j + c) + r, sw = (key >> 1) & 7; const LAS unsigned char* kp = F.lds + L_K + key * 128;
            f32x16 acc;
#pragma unroll
            for (int i = 0; i < 16; ++i) acc[i] = 0.f;
#pragma unroll
            for (int s = 0; s < 4; ++s) { const bf16x8 a = *(const LAS bf16x8*)(kp + (((2 * s + h) ^ sw) << 4)); acc = ATT_MFMA(a, Qf[s], acc); }
            S[c] = acc; }
        float m = sinkv;
#pragma unroll
        for (int c = 0; c < 5; ++c) { const bool tile_ok = !(nb == 0 && (j + c) < 4);
#pragma unroll
            for (int i = 0; i < 16; ++i) { const int kk0 = (i & 3) + 8 * (i >> 2); const int dist = dl + 128 - 32 * c - kk0;
                bool ok = tile_ok; if (c == 0) ok = ok && (dist <= 127); if (c == 4) ok = ok && (dist >= 0);
                const float sv = ok ? S[c][i] + tab[dist & 127] : -INFINITY; S[c][i] = sv; m = fmaxf(m, sv); } }
        m = fmaxf(m, __shfl_xor(m, 32));
        float ls = 0.f;
#pragma unroll
        for (int c = 0; c < 5; ++c)
#pragma unroll
            for (int i = 0; i < 16; ++i) { const float p = __builtin_amdgcn_exp2f(S[c][i] - m); S[c][i] = p; ls += p; }
        ls += __shfl_xor(ls, 32);
        const float inv = 1.f / (ls + __builtin_amdgcn_exp2f(sinkv - m));
        f32x16 O0, O1;
#pragma unroll
        for (int i = 0; i < 16; ++i) { O0[i] = 0.f; O1[i] = 0.f; }
#pragma unroll
        for (int c = 0; c < 5; ++c)
#pragma unroll
            for (int sp = 0; sp < 2; ++sp) {
                v4u pw; pw.x = pg8::cvt_pk_bf16(S[c][8 * sp + 0] * inv, S[c][8 * sp + 1] * inv); pw.y = pg8::cvt_pk_bf16(S[c][8 * sp + 2] * inv, S[c][8 * sp + 3] * inv);
                pw.z = pg8::cvt_pk_bf16(S[c][8 * sp + 4] * inv, S[c][8 * sp + 5] * inv); pw.w = pg8::cvt_pk_bf16(S[c][8 * sp + 6] * inv, S[c][8 * sp + 7] * inv);
                const bf16x8 Pf = __builtin_bit_cast(bf16x8, pw);
                const int keybase = 32 * (j + c) + 16 * sp + 4 * h;
                { const LAS unsigned char* vp = F.lds + L_VT + r * VROWB + keybase * 2; const s16x4 lo = *(const LAS s16x4*)vp, hi = *(const LAS s16x4*)(vp + 16);
                  const bf16x8 Vf = {lo[0], lo[1], lo[2], lo[3], hi[0], hi[1], hi[2], hi[3]}; O0 = ATT_MFMA(Vf, Pf, O0); }
                { const LAS unsigned char* vp = F.lds + L_VT + (32 + r) * VROWB + keybase * 2; const s16x4 lo = *(const LAS s16x4*)vp, hi = *(const LAS s16x4*)(vp + 16);
                  const bf16x8 Vf = {lo[0], lo[1], lo[2], lo[3], hi[0], hi[1], hi[2], hi[3]}; O1 = ATT_MFMA(Vf, Pf, O1); }
            }
        const bf16* agp = AG + tok * 1024 + hq * 64 + 4 * h; bf16* yp = Y + tok * 2048 + hq * 64 + 4 * h;
#pragma unroll
        for (int g4 = 0; g4 < 4; ++g4) {
            { const uint2 a = *(const uint2*)(agp + 8 * g4); uint2 w; w.x = pg8::cvt_pk_bf16(O0[4 * g4 + 0] * bflo(a.x), O0[4 * g4 + 1] * bfhi(a.x)); w.y = pg8::cvt_pk_bf16(O0[4 * g4 + 2] * bflo(a.y), O0[4 * g4 + 3] * bfhi(a.y)); *(uint2*)(yp + 8 * g4) = w; }
            { const uint2 a = *(const uint2*)(agp + 32 + 8 * g4); uint2 w; w.x = pg8::cvt_pk_bf16(O1[4 * g4 + 0] * bflo(a.x), O1[4 * g4 + 1] * bfhi(a.x)); w.y = pg8::cvt_pk_bf16(O1[4 * g4 + 2] * bflo(a.y), O1[4 * g4 + 3] * bfhi(a.y)); *(uint2*)(yp + 32 + 8 * g4) = w; }
        }
    }
}
__device__ __forceinline__ void phase(Frame& F, int first, int stride) {
    if (first >= NUNITS) return;
    v4u kr[4], vr[4]; float bias;
    load_regs(F, first, kr, vr, bias);
    for (int u = first; u < NUNITS; u += stride) {
        write_lds(F, kr, vr, bias);
        __syncthreads();
        if (u + stride < NUNITS) load_regs(F, u + stride, kr, vr, bias);
        compute(F, u);
        __syncthreads();
    }
}
#undef ATT_MFMA
}


namespace hg {
typedef short bf16x8 __attribute__((ext_vector_type(8)));
typedef short s16x4 __attribute__((ext_vector_type(4)));
typedef float f32x16 __attribute__((ext_vector_type(16)));
typedef float f32x2v __attribute__((ext_vector_type(2)));
typedef unsigned u32x2v __attribute__((ext_vector_type(2)));
constexpr int TP = 136;
constexpr int L_QG = 0, L_KN = 16384, L_KDT = 32768, L_VT = L_KDT + 128 * TP, L_ST = L_VT + 128 * TP, L_DEC = L_ST + 32768, L_TOT = L_DEC + 512, L_END = L_TOT + 4096, L_OB = 0;
static_assert(L_END <= RING_BYTES && (L_VT % 16) == 0 && (L_ST % 16) == 0 && (L_DEC % 16) == 0 && (L_TOT % 16) == 0, "hgrn LDS map");
#define HG_MFMA(a, b, c) __builtin_amdgcn_mfma_f32_32x32x16_bf16((a), (b), (c), 0, 0, 0)
struct Pre { unsigned q2[8], lf2[8]; v4u va, vb, hg0, hg1; };
__device__ __forceinline__ void load_chunk(Frame& F, int b, int h, int c, Pre& P) {
    const bf16* HQ = (const bf16*)(F.ws + WS_HQ); const bf16* LF = (const bf16*)(F.ws + WS_LF); const bf16* HI = (const bf16*)(F.ws + WS_HI); const bf16* HG = (const bf16*)(F.ws + WS_HG);
    const size_t tokc = (size_t)b * SEQ + 64 * c;
#pragma unroll
    for (int i = 0; i < 8; ++i) { const size_t o = (tokc + 8 * F.wave + i) * 1024 + h * 128 + 2 * F.lane; P.q2[i] = *(const unsigned*)(HQ + o); P.lf2[i] = *(const unsigned*)(LF + o); }
    { const int sp = F.tid & 31, ch = F.tid >> 5; const size_t o = (tokc + 2 * sp) * 1024 + h * 128 + ch * 8; P.va = *(const v4u*)(HI + o); P.vb = *(const v4u*)(HI + o + 1024); }
    { const int t = F.tid >> 3, ec = F.tid & 7; const size_t o = (tokc + t) * 1024 + h * 128 + 16 * ec; P.hg0 = *(const v4u*)(HG + o); P.hg1 = *(const v4u*)(HG + o + 8); }
}
__device__ __forceinline__ void unit(Frame& F, int u) {
    const int b = u >> 3, h = u & 7;
    const int lane = F.lane, wave = F.wave, r = lane & 31, hh = lane >> 5;
    const int tb = wave >> 2, eb = wave & 3, db = wave >> 1, eb2 = 2 * (wave & 1);
    bf16* Y = (bf16*)(F.ws + WS_Y12);
    for (int i = F.tid; i < 32768 / 16; i += 512) *(LAS v4u*)(F.lds + L_ST + i * 16) = (v4u){0u, 0u, 0u, 0u};
    f32x16 S0, S1;
#pragma unroll
    for (int i = 0; i < 16; ++i) { S0[i] = 0.f; S1[i] = 0.f; }
    Pre P; load_chunk(F, b, h, 0, P);
    for (int c = 0; c < SEQ / 64; ++c) {
        const size_t tokc = (size_t)b * SEQ + 64 * c;
        float pa[8], pb[8]; float ra = 0.f, rb = 0.f;
#pragma unroll
        for (int i = 0; i < 8; ++i) { ra += bflo(P.lf2[i]); rb += bfhi(P.lf2[i]); pa[i] = ra; pb[i] = rb; }
        *(LAS f32x2v*)(F.lds + L_TOT + (wave * 128 + 2 * lane) * 4) = (f32x2v){ra, rb};
        __syncthreads();
        float offa = 0.f, offb = 0.f, gla = 0.f, glb = 0.f;
#pragma unroll
        for (int sgm = 0; sgm < 8; ++sgm) { const f32x2v t2 = *(const LAS f32x2v*)(F.lds + L_TOT + (sgm * 128 + 2 * lane) * 4); if (sgm < wave) { offa += t2.x; offb += t2.y; } gla += t2.x; glb += t2.y; }
        float kda[8], kdb[8];
#pragma unroll
        for (int i = 0; i < 8; ++i) { const int t = 8 * wave + i;
            const float ga = offa + pa[i], gb = offb + pb[i];
            const float ka = 1.f - __expf(bflo(P.lf2[i])), kb = 1.f - __expf(bfhi(P.lf2[i]));
            const float qga = bflo(P.q2[i]) * __expf(ga), qgb = bfhi(P.q2[i]) * __expf(gb);
            const float kna = ka * __expf(-ga), knb = kb * __expf(-gb);
            kda[i] = ka * __expf(gla - ga); kdb[i] = kb * __expf(glb - gb);
            const int off = t * 256 + (((lane >> 2) ^ (t & 15)) << 4) + (lane & 3) * 4;
            *(LAS unsigned*)(F.lds + L_QG + off) = pg8::cvt_pk_bf16(qga, qgb);
            *(LAS unsigned*)(F.lds + L_KN + off) = pg8::cvt_pk_bf16(kna, knb); }
        { LAS unsigned char* ka_p = F.lds + L_KDT + (2 * lane) * TP + 16 * wave; LAS unsigned char* kb_p = ka_p + TP;
          u32x2v w;
          w.x = pg8::cvt_pk_bf16(kda[0], kda[1]); w.y = pg8::cvt_pk_bf16(kda[2], kda[3]); *(LAS u32x2v*)(ka_p) = w;
          w.x = pg8::cvt_pk_bf16(kda[4], kda[5]); w.y = pg8::cvt_pk_bf16(kda[6], kda[7]); *(LAS u32x2v*)(ka_p + 8) = w;
          w.x = pg8::cvt_pk_bf16(kdb[0], kdb[1]); w.y = pg8::cvt_pk_bf16(kdb[2], kdb[3]); *(LAS u32x2v*)(kb_p) = w;
          w.x = pg8::cvt_pk_bf16(kdb[4], kdb[5]); w.y = pg8::cvt_pk_bf16(kdb[6], kdb[7]); *(LAS u32x2v*)(kb_p + 8) = w; }
        if (wave == 0) *(LAS f32x2v*)(F.lds + L_DEC + 2 * lane * 4) = (f32x2v){__expf(gla), __expf(glb)};
        { const int sp = F.tid & 31, ch = F.tid >> 5; const v4u a = P.va, cc = P.vb; LAS unsigned char* base = F.lds + L_VT + (ch * 8) * TP + sp * 4;
          *(LAS unsigned*)(base + 0 * TP) = (a.x & 0xffffu) | (cc.x << 16);  *(LAS unsigned*)(base + 1 * TP) = (a.x >> 16) | (cc.x & 0xffff0000u);
          *(LAS unsigned*)(base + 2 * TP) = (a.y & 0xffffu) | (cc.y << 16);  *(LAS unsigned*)(base + 3 * TP) = (a.y >> 16) | (cc.y & 0xffff0000u);
          *(LAS unsigned*)(base + 4 * TP) = (a.z & 0xffffu) | (cc.z << 16);  *(LAS unsigned*)(base + 5 * TP) = (a.z >> 16) | (cc.z & 0xffff0000u);
          *(LAS unsigned*)(base + 6 * TP) = (a.w & 0xffffu) | (cc.w << 16);  *(LAS unsigned*)(base + 7 * TP) = (a.w >> 16) | (cc.w & 0xffff0000u); }
        const v4u hgw0 = P.hg0, hgw1 = P.hg1;
        __syncthreads();
        if (c + 1 < SEQ / 64) load_chunk(F, b, h, c + 1, P);
        f32x16 O;
#pragma unroll
        for (int i = 0; i < 16; ++i) O[i] = 0.f;
        bf16x8 qf[8];
        { const LAS unsigned char* qrow = F.lds + L_QG + (32 * tb + r) * 256; const LAS unsigned char* srow = F.lds + L_ST + (32 * eb + r) * 256;
#pragma unroll
          for (int ks = 0; ks < 8; ++ks) { const int sw = ((2 * ks + hh) ^ (r & 15)) << 4; qf[ks] = *(const LAS bf16x8*)(qrow + sw); const bf16x8 sf = *(const LAS bf16x8*)(srow + sw); O = HG_MFMA(qf[ks], sf, O); } }
#pragma unroll
        for (int sb = 0; sb < 2; ++sb) {
            if (sb <= tb) {
                f32x16 X;
#pragma unroll
                for (int i = 0; i < 16; ++i) X[i] = 0.f;
                const LAS unsigned char* krow = F.lds + L_KN + (32 * sb + r) * 256;
#pragma unroll
                for (int ks = 0; ks < 8; ++ks) { const bf16x8 kf = *(const LAS bf16x8*)(krow + (((2 * ks + hh) ^ (r & 15)) << 4)); X = HG_MFMA(kf, qf[ks], X); }
                if (sb == tb) {
#pragma unroll
                    for (int i = 0; i < 16; ++i) { const int cr = (i & 3) + 8 * (i >> 2) + 4 * hh; X[i] = (cr <= r) ? X[i] : 0.f; } }
#pragma unroll
                for (int sp = 0; sp < 2; ++sp) {
                    v4u pw; pw.x = pg8::cvt_pk_bf16(X[8 * sp + 0], X[8 * sp + 1]); pw.y = pg8::cvt_pk_bf16(X[8 * sp + 2], X[8 * sp + 3]); pw.z = pg8::cvt_pk_bf16(X[8 * sp + 4], X[8 * sp + 5]); pw.w = pg8::cvt_pk_bf16(X[8 * sp + 6], X[8 * sp + 7]);
                    const LAS unsigned char* vp = F.lds + L_VT + (32 * eb + r) * TP + (32 * sb + 16 * sp + 4 * hh) * 2; const s16x4 lo = *(const LAS s16x4*)vp, hi = *(const LAS s16x4*)(vp + 16);
                    const bf16x8 vf = {lo[0], lo[1], lo[2], lo[3], hi[0], hi[1], hi[2], hi[3]};
                    O = HG_MFMA(__builtin_bit_cast(bf16x8, pw), vf, O); }
            }
        }
#pragma unroll
        for (int g4 = 0; g4 < 4; ++g4) { const f32x4 dv = *(const LAS f32x4*)(F.lds + L_DEC + (32 * db + 8 * g4 + 4 * hh) * 4);
#pragma unroll
            for (int jx = 0; jx < 4; ++jx) { S0[4 * g4 + jx] *= dv[jx]; S1[4 * g4 + jx] *= dv[jx]; } }
#pragma unroll
        for (int ks = 0; ks < 4; ++ks) {
            const LAS unsigned char* kp = F.lds + L_KDT + (32 * db + r) * TP + (16 * ks + 8 * hh) * 2; const s16x4 k0 = *(const LAS s16x4*)kp, k1 = *(const LAS s16x4*)(kp + 8);
            const bf16x8 kf = {k0[0], k0[1], k0[2], k0[3], k1[0], k1[1], k1[2], k1[3]};
            { const LAS unsigned char* vp = F.lds + L_VT + (32 * eb2 + r) * TP + (16 * ks + 8 * hh) * 2; const s16x4 v0 = *(const LAS s16x4*)vp, v1 = *(const LAS s16x4*)(vp + 8);
              const bf16x8 vf = {v0[0], v0[1], v0[2], v0[3], v1[0], v1[1], v1[2], v1[3]}; S0 = HG_MFMA(kf, vf, S0); }
            { const LAS unsigned char* vp = F.lds + L_VT + (32 * (eb2 + 1) + r) * TP + (16 * ks + 8 * hh) * 2; const s16x4 v0 = *(const LAS s16x4*)vp, v1 = *(const LAS s16x4*)(vp + 8);
              const bf16x8 vf = {v0[0], v0[1], v0[2], v0[3], v1[0], v1[1], v1[2], v1[3]}; S1 = HG_MFMA(kf, vf, S1); }
        }
        __syncthreads();
#pragma unroll
        for (int g4 = 0; g4 < 4; ++g4) { const int ch = 4 * db + g4;
            { const int e = 32 * eb2 + r; u32x2v w; w.x = pg8::cvt_pk_bf16(S0[4 * g4 + 0], S0[4 * g4 + 1]); w.y = pg8::cvt_pk_bf16(S0[4 * g4 + 2], S0[4 * g4 + 3]);
              *(LAS u32x2v*)(F.lds + L_ST + e * 256 + ((ch ^ (e & 15)) << 4) + 8 * hh) = w; }
            { const int e = 32 * (eb2 + 1) + r; u32x2v w; w.x = pg8::cvt_pk_bf16(S1[4 * g4 + 0], S1[4 * g4 + 1]); w.y = pg8::cvt_pk_bf16(S1[4 * g4 + 2], S1[4 * g4 + 3]);
              *(LAS u32x2v*)(F.lds + L_ST + e * 256 + ((ch ^ (e & 15)) << 4) + 8 * hh) = w; } }
#pragma unroll
        for (int i = 0; i < 16; ++i) { const int t = 32 * tb + (i & 3) + 8 * (i >> 2) + 4 * hh; *(LAS float*)(F.lds + L_OB + t * 512 + (32 * eb + r) * 4) = O[i]; }
        __syncthreads();
        { const int t = F.tid >> 3, ec = F.tid & 7; const LAS unsigned char* op = F.lds + L_OB + t * 512 + ec * 64;
          const f32x4 o0 = *(const LAS f32x4*)(op), o1 = *(const LAS f32x4*)(op + 16), o2 = *(const LAS f32x4*)(op + 32), o3 = *(const LAS f32x4*)(op + 48);
          float ss = (o0.x * o0.x + o0.y * o0.y) + (o0.z * o0.z + o0.w * o0.w) + (o1.x * o1.x + o1.y * o1.y) + (o1.z * o1.z + o1.w * o1.w) + (o2.x * o2.x + o2.y * o2.y) + (o2.z * o2.z + o2.w * o2.w) + (o3.x * o3.x + o3.y * o3.y) + (o3.z * o3.z + o3.w * o3.w);
          ss += __shfl_xor(ss, 1); ss += __shfl_xor(ss, 2); ss += __shfl_xor(ss, 4);
          const float rstd = 1.f / sqrtf(ss * (1.f / 128.f) + NORM_EPS);
          const float* gp = F.hgrn_norm + h * 128 + 16 * ec; const f32x4 n0 = *(const f32x4*)(gp), n1 = *(const f32x4*)(gp + 4), n2 = *(const f32x4*)(gp + 8), n3 = *(const f32x4*)(gp + 12);
          v4u w0, w1;
          w0.x = pg8::cvt_pk_bf16(o0.x * rstd * n0.x * bflo(hgw0.x), o0.y * rstd * n0.y * bfhi(hgw0.x)); w0.y = pg8::cvt_pk_bf16(o0.z * rstd * n0.z * bflo(hgw0.y), o0.w * rstd * n0.w * bfhi(hgw0.y));
          w0.z = pg8::cvt_pk_bf16(o1.x * rstd * n1.x * bflo(hgw0.z), o1.y * rstd * n1.y * bfhi(hgw0.z)); w0.w = pg8::cvt_pk_bf16(o1.z * rstd * n1.z * bflo(hgw0.w), o1.w * rstd * n1.w * bfhi(hgw0.w));
          w1.x = pg8::cvt_pk_bf16(o2.x * rstd * n2.x * bflo(hgw1.x), o2.y * rstd * n2.y * bfhi(hgw1.x)); w1.y = pg8::cvt_pk_bf16(o2.z * rstd * n2.z * bflo(hgw1.y), o2.w * rstd * n2.w * bfhi(hgw1.y));
          w1.z = pg8::cvt_pk_bf16(o3.x * rstd * n3.x * bflo(hgw1.z), o3.y * rstd * n3.y * bfhi(hgw1.z)); w1.w = pg8::cvt_pk_bf16(o3.z * rstd * n3.z * bflo(hgw1.w), o3.w * rstd * n3.w * bfhi(hgw1.w));
          bf16* yp = Y + (tokc + t) * 2048 + 1024 + h * 128 + 16 * ec; *(v4u*)yp = w0; *(v4u*)(yp + 8) = w1; }
    }
    __syncthreads();
}
#undef HG_MFMA
}

__device__ __forceinline__ void hgrn_naive(Frame& F) {
    const bf16* HQ = (const bf16*)(F.ws + WS_HQ); const bf16* LF = (const bf16*)(F.ws + WS_LF); const bf16* HI = (const bf16*)(F.ws + WS_HI);
    float* OR = (float*)(F.ws + WS_ORAW);
    LAS unsigned char* sQ = F.lds;
    LAS unsigned char* sF = F.lds + 8192;
    LAS unsigned char* sV = F.lds + 16384;
    LAS float* sP = (LAS float*)(F.lds + 32768);
    for (int unit = blockIdx.x; unit < 256; unit += F.G) {
        const int bh = unit >> 1, eh = unit & 1, b = bh >> 3, h = bh & 7;
        float S[16];
#pragma unroll
        for (int i = 0; i < 16; ++i) S[i] = 0.f;
        for (int blk = 0; blk < SEQ / 32; ++blk) {
            const size_t tok0 = (size_t)b * SEQ + blk * 32;
            { const int r = F.tid >> 4, c = F.tid & 15;
              *(LAS v4u*)(sQ + F.tid * 16) = *(const v4u*)(HQ + (tok0 + r) * 1024 + h * 128 + c * 8);
              *(LAS v4u*)(sF + F.tid * 16) = *(const v4u*)(LF + (tok0 + r) * 1024 + h * 128 + c * 8);
              if (F.tid < 256) { const int r2 = F.tid >> 3, c2 = F.tid & 7; *(LAS v4u*)(sV + F.tid * 16) = *(const v4u*)(HI + (tok0 + r2) * 1024 + h * 128 + eh * 64 + c2 * 8); } }
            __syncthreads();
            for (int t = 0; t < 32; ++t) {
                const v4u q0 = *(const LAS v4u*)(sQ + t * 256 + F.wave * 32), q1 = *(const LAS v4u*)(sQ + t * 256 + F.wave * 32 + 16);
                const v4u f0 = *(const LAS v4u*)(sF + t * 256 + F.wave * 32), f1 = *(const LAS v4u*)(sF + t * 256 + F.wave * 32 + 16);
                const unsigned short vb = *(const LAS unsigned short*)(sV + t * 128 + F.lane * 2);
                const float v = __uint_as_float((unsigned)vb << 16);
                const unsigned qw[8] = {q0.x, q0.y, q0.z, q0.w, q1.x, q1.y, q1.z, q1.w};
                const unsigned fw[8] = {f0.x, f0.y, f0.z, f0.w, f1.x, f1.y, f1.z, f1.w};
                float o = 0.f;
#pragma unroll
                for (int j = 0; j < 8; ++j) {
                    { const float f = __expf(bflo(fw[j])), k = 1.f - f; S[2 * j] = f * S[2 * j] + k * v; o += bflo(qw[j]) * S[2 * j]; }
                    { const float f = __expf(bfhi(fw[j])), k = 1.f - f; S[2 * j + 1] = f * S[2 * j + 1] + k * v; o += bfhi(qw[j]) * S[2 * j + 1]; }
                }
                sP[(F.wave * 32 + t) * 64 + F.lane] = o;
            }
            __syncthreads();
#pragma unroll
            for (int r = 0; r < 4; ++r) { const int idx = F.tid + 512 * r, t = idx >> 6, e = idx & 63; float s = 0.f;
#pragma unroll
                for (int w = 0; w < 8; ++w) s += sP[(w * 32 + t) * 64 + e];
                OR[(tok0 + t) * 1024 + h * 128 + eh * 64 + e] = s; }
        }
        __syncthreads();
    }
}
__device__ __forceinline__ void hgrn_norm_gate(Frame& F) {
    const float* OR = (const float*)(F.ws + WS_ORAW); const bf16* HG = (const bf16*)(F.ws + WS_HG); bf16* Y = (bf16*)(F.ws + WS_Y12);
    const int gw = F.vcu * NWAVES + F.wave, NGW = F.G * NWAVES;
    for (int tok = gw; tok < M; tok += NGW) {
        const int c0 = F.lane * 16;
        f32x4 v[4]; float s = 0.f;
#pragma unroll
        for (int j = 0; j < 4; ++j) { v[j] = *(const f32x4*)(OR + (size_t)tok * 1024 + c0 + 4 * j); s += (v[j].x * v[j].x + v[j].y * v[j].y) + (v[j].z * v[j].z + v[j].w * v[j].w); }
        s += __shfl_xor(s, 1); s += __shfl_xor(s, 2); s += __shfl_xor(s, 4);
        const float rstd = 1.f / sqrtf(s * (1.f / 128.f) + NORM_EPS);
        const v4u g0 = *(const v4u*)(HG + (size_t)tok * 1024 + c0), g1 = *(const v4u*)(HG + (size_t)tok * 1024 + c0 + 8);
        const f32x4 n0 = *(const f32x4*)(F.hgrn_norm + c0), n1 = *(const f32x4*)(F.hgrn_norm + c0 + 4), n2 = *(const f32x4*)(F.hgrn_norm + c0 + 8), n3 = *(const f32x4*)(F.hgrn_norm + c0 + 12);
        v4u w0, w1;
        w0.x = pk2(v[0].x * rstd * n0.x * bflo(g0.x), v[0].y * rstd * n0.y * bfhi(g0.x)); w0.y = pk2(v[0].z * rstd * n0.z * bflo(g0.y), v[0].w * rstd * n0.w * bfhi(g0.y));
        w0.z = pk2(v[1].x * rstd * n1.x * bflo(g0.z), v[1].y * rstd * n1.y * bfhi(g0.z)); w0.w = pk2(v[1].z * rstd * n1.z * bflo(g0.w), v[1].w * rstd * n1.w * bfhi(g0.w));
        w1.x = pk2(v[2].x * rstd * n2.x * bflo(g1.x), v[2].y * rstd * n2.y * bfhi(g1.x)); w1.y = pk2(v[2].z * rstd * n2.z * bflo(g1.y), v[2].w * rstd * n2.w * bfhi(g1.y));
        w1.z = pk2(v[3].x * rstd * n3.x * bflo(g1.z), v[3].y * rstd * n3.y * bfhi(g1.z)); w1.w = pk2(v[3].z * rstd * n3.z * bflo(g1.w), v[3].w * rstd * n3.w * bfhi(g1.w));
        *(v4u*)(Y + (size_t)tok * 2048 + 1024 + c0) = w0; *(v4u*)(Y + (size_t)tok * 2048 + 1024 + c0 + 8) = w1;
    }
}
__device__ __forceinline__ void final_norm(Frame& F) {
    const float* Yo = (const float*)(F.ws + WS_YOUT);
    const int gw = F.vcu * NWAVES + F.wave, NGW = F.G * NWAVES;
    for (int m = gw; m < M; m += NGW) {
        const f32x4* yr = (const f32x4*)(Yo + (size_t)m * D) + F.lane; const f32x4* xr = (const f32x4*)(F.x + (size_t)m * D) + F.lane; const f32x4* gr = (const f32x4*)F.norm_post + F.lane;
        f32x4* orow = (f32x4*)(F.out + (size_t)m * D) + F.lane;
        f32x4 v[8]; float s = 0.f;
#pragma unroll
        for (int j = 0; j < 8; ++j) { v[j] = yr[64 * j]; s += (v[j].x * v[j].x + v[j].y * v[j].y) + (v[j].z * v[j].z + v[j].w * v[j].w); }
        const float rstd = 1.f / sqrtf(wave_sum(s) * (1.f / D) + NORM_EPS);
#pragma unroll
        for (int j = 0; j < 8; ++j) { const f32x4 g = gr[64 * j], xv = xr[64 * j]; orow[64 * j] = xv + v[j] * rstd * g; }
    }
}

struct Args { const float* in[11]; float* out; unsigned char* ws; int ph_lo, ph_hi, li, pad; };
__global__ void __launch_bounds__(NWAVES * 64, 2) fwd_kernel(Args args) {
    extern __shared__ __attribute__((aligned(16))) unsigned char lds[];
    Frame F;
    F.lds = (LAS unsigned char*)lds;
    F.MISC = (volatile LAS unsigned*)(F.lds + MISC_OFF);
    F.tid = threadIdx.x; F.lane = F.tid & 63; F.wave = __builtin_amdgcn_readfirstlane(F.tid >> 6);
    F.G = gridDim.x; { const int bx = blockIdx.x; F.vcu = (F.G % 8 == 0) ? (bx % 8) * (F.G / 8) + bx / 8 : bx; }
    F.ws = args.ws; F.ctl = (gu32*)(args.ws + WS_CTL);
    F.x = args.in[0]; F.norm_pre = args.in[1]; F.w_in = args.in[2]; F.rel_bias = args.in[3]; F.sinks = args.in[4]; F.lb_logits = args.in[5]; F.hgrn_norm = args.in[6];
    F.w_a = args.in[7]; F.w_h = args.in[8]; F.w_out = args.in[9]; F.norm_post = args.in[10]; F.out = args.out;
    for (int u = F.tid; u < (LDS_BYTES - LDSCTL_OFF) / 4; u += NWAVES * 64) ((LAS unsigned*)(F.lds + LDSCTL_OFF))[u] = 0u;
    __syncthreads();
    XcdBarrier bar; bar.bar = (unsigned*)(F.ctl + CW_BAR); bar.x = 0; bar.st = nullptr;
    if (N_LAUNCHES != PER_PHASE) bar = xcd_barrier_post((unsigned*)(F.ctl + CW_BAR), F.MISC + 8);
#define GRID_BAR(seam) do { if (N_LAUNCHES == PER_PHASE) { if (F.tid == 0) __hip_atomic_store(F.ctl + CW_TMO, 0xBADBA0u | (unsigned)(seam), RLX_AGENT); } else { xcd_barrier(bar); } } while (0)
    const int lo = args.ph_lo, hi = args.ph_hi;
#define IN(k) (lo <= (k) && (k) < hi)
#define BOTH(k) (IN(k) && IN((k) + 1))
    if (IN(0)) { p0_prologue(F); if (BOTH(0)) GRID_BAR(0); }
    if (IN(1)) {
        pg8::Gemm g{(const bf16*)(F.ws + WS_H), (const bf16*)(F.ws + WS_WIN), M, NIN, D, LDH}; pg8::StaticOrder S; S.init(M, NIN, F.G, (int)blockIdx.x);
        EpiProj E{F.ws};
        pg8::gemm_phase<EpiProj, pg8::StaticOrder>(F.lds + RING_OFF, g, S, E);
        if (BOTH(1)) GRID_BAR(1);
    }
    if (IN(2)) {
        if (F.G == 256) { const int bx = (int)blockIdx.x, grp = (bx >> 3) & 1, idx = (bx >> 4) * 8 + (bx & 7);
            if (grp == 0) hg::unit(F, idx); else att::phase(F, idx, 128); }
        else { att::phase(F, (int)blockIdx.x, F.G); for (int u = (int)blockIdx.x; u < 128; u += F.G) hg::unit(F, u); }
        if (BOTH(2)) GRID_BAR(2); }
    if (IN(3)) {   }
    if (IN(4)) {
        pg8::Gemm g{(const bf16*)(F.ws + WS_Y12), (const bf16*)(F.ws + WS_W2), M, D, 1024, 2048}; pg8::BranchOrder S; S.init(M, D, F.G, (int)blockIdx.x);
        EpiMerge E{F.ws};
        pg8::gemm_phase<EpiMerge, pg8::BranchOrder>(F.lds + RING_OFF, g, S, E);
        if (BOTH(4)) GRID_BAR(4);
    }
    if (IN(5)) {
        pg8::Gemm g{(const bf16*)(F.ws + WS_MERGED), (const bf16*)(F.ws + WS_WO), M, D, D, D}; pg8::StaticOrder S; S.init(M, D, F.G, (int)blockIdx.x);
        pg8::EpiF32 E{(float*)(F.ws + WS_YOUT), D};
        pg8::gemm_phase<pg8::EpiF32, pg8::StaticOrder>(F.lds + RING_OFF, g, S, E);
        if (BOTH(5)) GRID_BAR(5);
    }
    if (IN(6)) { final_norm(F); }
#undef IN
#undef BOTH
}

extern "C" void kernel_launch(void* const* d_in, const int* in_sizes, int n_in, void* d_out, int out_size, void* d_ws, size_t ws_size, hipStream_t stream) {
    static int grid = 0;
    if (grid == 0) {
        if (n_in != 11 || in_sizes[0] != M * D || out_size != M * D || ws_size < WS_END) { fprintf(stderr, "kernel_launch: unexpected shapes: n_in %d in0 %d out %d ws %zu\n", n_in, n_in > 0 ? in_sizes[0] : -1, out_size, ws_size); grid = -1; return; }
        int dev = 0, cus = 0, per_cu = 0;
        if (hipGetDevice(&dev) != hipSuccess || hipDeviceGetAttribute(&cus, hipDeviceAttributeMultiprocessorCount, dev) != hipSuccess) { grid = -1; return; }
        if (hipFuncSetAttribute((const void*)fwd_kernel, hipFuncAttributeMaxDynamicSharedMemorySize, LDS_BYTES) != hipSuccess) { fprintf(stderr, "kernel_launch: hipFuncSetAttribute failed\n"); grid = -1; return; }
        if (hipOccupancyMaxActiveBlocksPerMultiprocessor(&per_cu, (const void*)fwd_kernel, NWAVES * 64, LDS_BYTES) != hipSuccess || per_cu < 1) { fprintf(stderr, "kernel_launch: occupancy query says %d blocks per CU\n", per_cu); }
        (void)hipGetLastError();
        grid = cus;
    }
    if (grid < 0) return;
    if (hipMemsetAsync((char*)d_ws + WS_CTL, 0, CTL_ZERO_BYTES, stream) != hipSuccess) { fprintf(stderr, "kernel_launch: memset failed\n"); return; }
    Args a{};
    for (int i = 0; i < 11; ++i) a.in[i] = (const float*)d_in[i];
    a.out = (float*)d_out; a.ws = (unsigned char*)d_ws;
    for (int li = 0; li < N_LAUNCHES; ++li) {
        a.ph_lo = (N_LAUNCHES == PER_PHASE) ? li : 0; a.ph_hi = (N_LAUNCHES == PER_PHASE) ? li + 1 : PER_PHASE; a.li = li;
        hipLaunchKernelGGL(fwd_kernel, dim3(grid), dim3(NWAVES * 64), LDS_BYTES, stream, a);
        const hipError_t le = hipPeekAtLastError();
        if (le != hipSuccess) { fprintf(stderr, "kernel_launch: launch %d failed: %s\n", li, hipGetErrorName(le)); break; }
    }
}
```

```cpp
#include <hip/hip_runtime.h>
#include <cstdio>

#ifndef MK_N_LAUNCHES
#define MK_N_LAUNCHES 1
#endif

namespace pg8 {
#define PG8_LAS __attribute__((address_space(3)))
typedef unsigned short bf16_t;
typedef short bf16x8 __attribute__((ext_vector_type(8)));
typedef float f32x4 __attribute__((ext_vector_type(4)));
typedef unsigned u32x4 __attribute__((ext_vector_type(4)));
constexpr int BM = 256, BK = 64, HALF = 128, HTB = HALF * BK * 2, STAGE_BYTES = 8 * HTB, NXCD = 8, WGM = 8;

__host__ __device__ __forceinline__ int lds_byte(int r, int c) { const int st = (r >> 4) * 2 + (c >> 5), rr = r & 15, cc = c & 31, ob = rr * 64 + cc * 2; return st * 1024 + (ob ^ (((ob >> 9) & 1) << 5)); }
__host__ __device__ __forceinline__ void stage_rc(int b, int& R, int& C) { const int st = b / 1024, sb = b % 1024, swz = sb ^ (((sb >> 9) & 1) << 5); R = (st >> 1) * 16 + swz / 64; C = (st & 1) * 32 + (swz % 64) / 2; }
__host__ __device__ __forceinline__ int perm32(int rho) { const int n = rho >> 4, i = rho & 15; return 8 * (i >> 2) + 4 * n + (i & 3); }

struct Unit { int pm, pn, br; };
struct Gemm { const bf16_t* A; const bf16_t* Bt; int M, N, K, ld; };

struct StaticOrder {
    int nM, nN, nwg, G, c;
    __host__ __device__ void init(int M, int N, int G_, int c_) { nM = M / BM; nN = N / BM; nwg = nM * nN; G = G_; c = c_; }
    __host__ __device__ bool tile(int i, int& pm, int& pn) const {
        const long L = (long)i * G + c; if (L >= nwg) return false;
        int wgid = (int)L; { const int q = nwg / NXCD, r = nwg % NXCD, xcd = wgid % NXCD, off = wgid / NXCD; wgid = (xcd < r ? xcd * (q + 1) : r * (q + 1) + (xcd - r) * q) + off; }
        const int nig = WGM * nN, gid = wgid / nig, fm = gid * WGM, gsz = (nM - fm) < WGM ? (nM - fm) : WGM;
        pm = fm + ((wgid % nig) % gsz); pn = (wgid % nig) / gsz; return true;
    }
    __host__ __device__ bool next(int i, Unit& u) const { u.br = 0; return tile(i, u.pm, u.pn); }
    __device__ __forceinline__ bool keep(const Unit&) const { return false; }
};
struct BranchOrder : StaticOrder {
    __host__ __device__ bool next(int v, Unit& u) const { u.br = v & 1; return tile(v >> 1, u.pm, u.pn); }
    __device__ __forceinline__ bool keep(const Unit& u) const { return u.br == 0; }
};

typedef float f32x2_t __attribute__((ext_vector_type(2)));
typedef __bf16 bf16x2_t __attribute__((ext_vector_type(2)));
__device__ __forceinline__ unsigned cvt_pk_bf16(float lo, float hi) { f32x2_t v = {lo, hi}; bf16x2_t b = __builtin_convertvector(v, bf16x2_t); return __builtin_bit_cast(unsigned, b); }
__device__ __forceinline__ float bf_lo(unsigned w) { return __uint_as_float(w << 16); }
__device__ __forceinline__ float bf_hi(unsigned w) { return __uint_as_float(w & 0xffff0000u); }

struct EpiF32 {
    static constexpr bool PERM = false;
    float* C; int ldc;
    __device__ __forceinline__ void operator()(f32x4 (&acc)[2][2][4][2], const Unit& u, int wr, int wc, int fr, int fq) const {
        const int row0 = u.pm * BM + wr * 64 + fr, col0 = u.pn * BM + wc * 32 + 4 * fq;
#pragma unroll
        for (int ai = 0; ai < 2; ++ai)
#pragma unroll
            for (int m = 0; m < 4; ++m) { float* rowp = C + (size_t)(row0 + ai * HALF + m * 16) * ldc + col0;
#pragma unroll
                for (int bj = 0; bj < 2; ++bj)
#pragma unroll
                    for (int n = 0; n < 2; ++n) *(f32x4*)(rowp + bj * HALF + n * 16) = acc[ai][bj][m][n]; }
    }
};

template <class Epi, class Sched>
__device__ __forceinline__ void gemm_phase(PG8_LAS unsigned char* lds, const Gemm g, const Sched& S, const Epi& E) {
    const int tid = threadIdx.x, wid = __builtin_amdgcn_readfirstlane(tid >> 6), lane = tid & 63, wr = wid >> 2, wc = wid & 3, fr = lane & 15, fq = lane >> 4;
    const int K = g.K, nt = K / BK, ld = g.ld;
    unsigned voffA[2], voffB[2];
#pragma unroll
    for (int i = 0; i < 2; ++i) { int R, C; stage_rc(tid * 16 + i * 8192, R, C); const int Rb = Epi::PERM ? ((R & ~31) + perm32(R & 31)) : R;
        voffA[i] = (unsigned)(R * ld + C) * 2u; voffB[i] = (unsigned)(Rb * ld + C) * 2u; }
    const size_t kstep = (size_t)(BK * 2);
    const size_t hstep = (size_t)HALF * ld * 2;
    const size_t tstep = 2 * hstep;
    const size_t brstep = (size_t)K * 2;
    const unsigned ldsw = (unsigned)wid * 1024u;
    const int aoff = lds_byte(wr * 64 + fr, fq * 8), boff = lds_byte(wc * 32 + fr, fq * 8);
#define PG8_SA(b, h) (((b) * 2 + (h)) * HTB)
#define PG8_SB(b, h) ((4 + (b) * 2 + (h)) * HTB)
#define PG8_STAGE(bufoff, gbase, voff) do { _Pragma("unroll") for (int _i = 0; _i < 2; ++_i) \
        __builtin_amdgcn_global_load_lds((const unsigned*)((const char*)(gbase) + (voff)[_i]), (PG8_LAS unsigned*)(lds + (bufoff) + ldsw + _i * 8192), 16, 0, 0); } while (0)
#define PG8_LDA(dst, b, h) do { _Pragma("unroll") for (int m = 0; m < 4; ++m) _Pragma("unroll") for (int k = 0; k < 2; ++k) dst[m][k] = *(const PG8_LAS bf16x8*)(lds + PG8_SA(b, h) + aoff + m * 2048 + k * 1024); } while (0)
#define PG8_LDB(dst, b, h) do { _Pragma("unroll") for (int n = 0; n < 2; ++n) _Pragma("unroll") for (int k = 0; k < 2; ++k) dst[n][k] = *(const PG8_LAS bf16x8*)(lds + PG8_SB(b, h) + boff + n * 2048 + k * 1024); } while (0)
#define PG8_MMA(ai, bj, At, Bt) do { __builtin_amdgcn_s_setprio(1); _Pragma("unroll") for (int m = 0; m < 4; ++m) _Pragma("unroll") for (int n = 0; n < 2; ++n) _Pragma("unroll") for (int k = 0; k < 2; ++k) \
        acc[ai][bj][m][n] = __builtin_amdgcn_mfma_f32_16x16x32_bf16(Bt[n][k], At[m][k], acc[ai][bj][m][n], 0, 0, 0); __builtin_amdgcn_s_setprio(0); } while (0)
#define PG8_WAIT_V(n) asm volatile("s_waitcnt vmcnt(" #n ")" ::: "memory")
#define PG8_WAIT_L(n) asm volatile("s_waitcnt lgkmcnt(" #n ")" ::: "memory")
#define PG8_BAR __builtin_amdgcn_s_barrier()
#define PG8_SCHED __builtin_amdgcn_sched_barrier(0)
    Unit cur, nxt; int ui = 0;
    if (!S.next(0, cur)) return;
    f32x4 acc[2][2][4][2];
#pragma unroll
    for (int a = 0; a < 2; ++a)
#pragma unroll
        for (int b = 0; b < 2; ++b)
#pragma unroll
            for (int m = 0; m < 4; ++m)
#pragma unroll
                for (int n = 0; n < 2; ++n) acc[a][b][m][n] = (f32x4){0.f, 0.f, 0.f, 0.f};
    bf16x8 At[4][2], B0[2][2], B1[2][2];
    const char* cA = (const char*)g.A + (size_t)cur.pm * tstep + (size_t)cur.br * brstep; const char* cB = (const char*)g.Bt + (size_t)cur.pn * tstep + (size_t)cur.br * brstep;
    PG8_STAGE(PG8_SB(0, 0), cB, voffB); PG8_STAGE(PG8_SB(0, 1), cB + hstep, voffB); PG8_STAGE(PG8_SA(0, 0), cA, voffA); PG8_STAGE(PG8_SA(0, 1), cA + hstep, voffA);
    if (wr == 1) PG8_BAR;
    PG8_WAIT_V(2); PG8_BAR;
    PG8_STAGE(PG8_SB(1, 0), cB + kstep, voffB); PG8_STAGE(PG8_SA(1, 0), cA + kstep, voffA); PG8_STAGE(PG8_SB(1, 1), cB + hstep + kstep, voffB);
    PG8_WAIT_V(6); PG8_BAR;
    for (;;) {
        const bool has_next = S.next(ui + 1, nxt);
        const char* nA = has_next ? (const char*)g.A + (size_t)nxt.pm * tstep + (size_t)nxt.br * brstep : cA; const char* nB = has_next ? (const char*)g.Bt + (size_t)nxt.pn * tstep + (size_t)nxt.br * brstep : cB;
        for (int t = 0; t < nt; t += 2) {
            const bool last = (t == nt - 2);
            const char* a1 = cA + (size_t)(t + 1) * kstep;
            const char* a2 = last ? nA : cA + (size_t)(t + 2) * kstep; const char* b2 = last ? nB : cB + (size_t)(t + 2) * kstep;
            const char* a3 = a2 + kstep; const char* b3 = b2 + kstep;
            PG8_LDB(B0, 0, 0); PG8_LDB(B1, 0, 1); PG8_SCHED; PG8_LDA(At, 0, 0); PG8_STAGE(PG8_SA(1, 1), a1 + hstep, voffA);
            PG8_WAIT_V(8); PG8_WAIT_L(0); PG8_BAR; PG8_MMA(0, 0, At, B0); PG8_MMA(0, 1, At, B1); PG8_BAR; PG8_SCHED;
            PG8_LDA(At, 0, 1); PG8_STAGE(PG8_SB(0, 0), b2, voffB); PG8_STAGE(PG8_SB(0, 1), b2 + hstep, voffB); PG8_STAGE(PG8_SA(0, 0), a2, voffA);
            PG8_WAIT_V(8); PG8_WAIT_L(0); PG8_BAR; PG8_MMA(1, 0, At, B0); PG8_MMA(1, 1, At, B1); PG8_BAR; PG8_SCHED;
            PG8_LDB(B0, 1, 0); PG8_LDB(B1, 1, 1); PG8_SCHED; PG8_LDA(At, 1, 0); PG8_STAGE(PG8_SA(0, 1), a2 + hstep, voffA);
            PG8_WAIT_V(8); PG8_WAIT_L(0); PG8_BAR; PG8_MMA(0, 0, At, B0); PG8_MMA(0, 1, At, B1); PG8_BAR; PG8_SCHED;
            PG8_LDA(At, 1, 1); PG8_STAGE(PG8_SB(1, 0), b3, voffB); PG8_STAGE(PG8_SB(1, 1), b3 + hstep, voffB); PG8_STAGE(PG8_SA(1, 0), a3, voffA);
            PG8_WAIT_V(8); PG8_WAIT_L(0); PG8_BAR; PG8_MMA(1, 0, At, B0); PG8_MMA(1, 1, At, B1); PG8_BAR; PG8_SCHED;
        }
        if (wr == 0) PG8_BAR;
        E(acc, cur, wr, wc, fr, fq);
        if (!has_next) break;
        if (!S.keep(cur)) {
#pragma unroll
            for (int a = 0; a < 2; ++a)
#pragma unroll
                for (int b = 0; b < 2; ++b)
#pragma unroll
                    for (int m = 0; m < 4; ++m)
#pragma unroll
                        for (int n = 0; n < 2; ++n) acc[a][b][m][n] = (f32x4){0.f, 0.f, 0.f, 0.f};
        }
        cur = nxt; cA = nA; cB = nB; ++ui;
        if (wr == 1) PG8_BAR;
    }
    PG8_WAIT_V(0);
    PG8_BAR;
#undef PG8_SA
#undef PG8_SB
#undef PG8_STAGE
#undef PG8_LDA
#undef PG8_LDB
#undef PG8_MMA
#undef PG8_WAIT_V
#undef PG8_WAIT_L
#undef PG8_BAR
#undef PG8_SCHED
}
}

constexpr int NWAVES = 8;
constexpr int N_LAUNCHES = MK_N_LAUNCHES;
constexpr int PER_PHASE = 7;
constexpr int BATCH = 16, SEQ = 2048, D = 2048, M = BATCH * SEQ;
constexpr int NIN = 10752;
constexpr int AW = 1024, KVW = 256, HW = 1024;
constexpr float NORM_EPS = 1e-6f;
constexpr float LOG2E = 1.4426950408889634f;
constexpr float QSCALE = 0.125f * LOG2E;

constexpr size_t MiB = 1u << 20;
constexpr size_t WS_CTL = 0, CTL_ZERO_BYTES = 1 * MiB;
constexpr size_t WS_BIAS = 1 * MiB;
constexpr size_t WS_LB = 1 * MiB + 65536;
constexpr size_t WS_WIN = 2 * MiB;
constexpr size_t WS_W2 = 44 * MiB;
constexpr size_t WS_WO = 52 * MiB;
constexpr size_t WS_H = 64 * MiB;
constexpr size_t WS_Y12 = WS_H;
constexpr size_t WS_Q = 192 * MiB, WS_K = 256 * MiB, WS_V = 272 * MiB, WS_AG = 288 * MiB, WS_HQ = 352 * MiB, WS_LF = 416 * MiB, WS_HI = 480 * MiB, WS_HG = 544 * MiB;
constexpr size_t WS_SA = 608 * MiB, WS_SH = 736 * MiB;
constexpr size_t WS_ORAW = 864 * MiB;
constexpr size_t WS_MERGED = 192 * MiB;
constexpr size_t WS_YOUT = 352 * MiB;
constexpr size_t WS_END = 992 * MiB;
constexpr int CW_TMO = 0, CW_CODE = 1;
constexpr int CW_BAR = 4096;

constexpr int RING_OFF = 0, RING_BYTES = 131072;
constexpr int LDSCTL_OFF = RING_BYTES, MISC_OFF = LDSCTL_OFF + 320;
constexpr int LDS_BYTES = 147456;

#define GAS __attribute__((address_space(1)))
#define LAS __attribute__((address_space(3)))
typedef unsigned short bf16;
typedef unsigned v4u __attribute__((ext_vector_type(4)));
typedef float f32x4 __attribute__((ext_vector_type(4)));
typedef GAS unsigned gu32;
#define RLX_AGENT __ATOMIC_RELAXED, __HIP_MEMORY_SCOPE_AGENT
#define LDS_WAIT() asm volatile("s_waitcnt lgkmcnt(0)" ::: "memory")
#define VM_WAIT() asm volatile("s_waitcnt vmcnt(0)" ::: "memory")
__device__ __forceinline__ unsigned f2bf(float f) { unsigned u = __builtin_bit_cast(unsigned, f); return (u + 0x7fffu + ((u >> 16) & 1u)) >> 16; }
__device__ __forceinline__ unsigned pk2(float lo, float hi) { return f2bf(lo) | (f2bf(hi) << 16); }
__device__ __forceinline__ float bflo(unsigned w) { return __uint_as_float(w << 16); }
__device__ __forceinline__ float bfhi(unsigned w) { return __uint_as_float(w & 0xffff0000u); }
__device__ __forceinline__ float fsigmoid(float x) { return __builtin_amdgcn_rcpf(1.f + __expf(-x)); }

#define XB_TMO      128
#define XB_XCNT(j)  (256  + 64 * (j))
#define XB_XSUB(j)  (1280 + 64 * (j))
#define XB_XGEN(j)  (2304 + 64 * (j))
#define XB_TOP      3328
#define XB_TOPGEN   3392
#define XCD_BAR_WORDS 3456
#define XB_SPIN_CAP (1u << 23)
__device__ __forceinline__ unsigned xb_ld(unsigned* p)              { return __hip_atomic_load(p, __ATOMIC_RELAXED, __HIP_MEMORY_SCOPE_AGENT); }
__device__ __forceinline__ unsigned xb_add(unsigned* p, unsigned v) { return __hip_atomic_fetch_add(p, v, __ATOMIC_RELAXED, __HIP_MEMORY_SCOPE_AGENT); }
__device__ __forceinline__ unsigned xb_xcc_id() { return (unsigned)__builtin_amdgcn_s_getreg((3 << 11) | 20) & 0xFu; }
#define XB_SPIN(cond, bar) do { unsigned _sp = 0; while (cond) { __builtin_amdgcn_s_sleep(1); \
    if ((++_sp & 255u) == 0u) { if (xb_ld(&(bar)[XB_TMO])) break; if (_sp > XB_SPIN_CAP) { atomicAdd(&(bar)[XB_TMO], 1u); break; } } } } while (0)
struct XcdBarrier { unsigned* bar; unsigned x; volatile LAS unsigned* st; };
__device__ __forceinline__ XcdBarrier xcd_barrier_post(unsigned* bar, volatile LAS unsigned* st) {
    XcdBarrier b; b.bar = bar; b.x = xb_xcc_id(); b.st = st;
    if (threadIdx.x == 0) (void)xb_add(&bar[XB_XCNT(b.x)], 1u);
    return b;
}
__device__ __forceinline__ void xcd_barrier_complete(unsigned* bar, unsigned x, unsigned& nloc, unsigned& nx) {
    const unsigned G = gridDim.x * gridDim.y * gridDim.z;
    unsigned sum, cnt, mine, sp = 0u;
    for (;;) {
        sum = 0u; cnt = 0u; mine = 0u;
#pragma unroll
        for (unsigned j = 0; j < 16; ++j) { const unsigned c = xb_ld(&bar[XB_XCNT(j)]); sum += c; cnt += (c > 0u) ? 1u : 0u; mine = (j == x) ? c : mine; }
        if (sum == G) break;
        __builtin_amdgcn_s_sleep(1);
        if ((++sp & 255u) == 0u) { if (xb_ld(&bar[XB_TMO])) break; if (sp > XB_SPIN_CAP) { atomicAdd(&bar[XB_TMO], 1u); break; } }
    }
    nloc = mine > 0u ? mine : 1u; nx = cnt > 0u ? cnt : 1u;
}
__device__ __forceinline__ void xcd_barrier(const XcdBarrier& b) {
    asm volatile("s_waitcnt vmcnt(0)" ::: "memory");
    __syncthreads();
    if (threadIdx.x == 0) {
        unsigned* bar = b.bar;
        __builtin_amdgcn_s_waitcnt(0);
        unsigned nloc = b.st[0], nx = b.st[1];
        if (nloc == 0u) { xcd_barrier_complete(bar, b.x, nloc, nx); b.st[0] = nloc; b.st[1] = nx; }
        const unsigned old = xb_add(&bar[XB_XSUB(b.x)], 1u);
        const unsigned gen = old / nloc;
        if (old + 1u == (gen + 1u) * nloc) {
            __builtin_amdgcn_fence(__ATOMIC_RELEASE, "agent");
            asm volatile("s_waitcnt vmcnt(0)" ::: "memory");
            const unsigned og = xb_add(&bar[XB_TOP], 1u);
            const unsigned tg = og / nx;
            if (og + 1u == (tg + 1u) * nx) xb_add(&bar[XB_TOPGEN], 1u);
            else XB_SPIN(xb_ld(&bar[XB_TOPGEN]) == tg, bar);
            __builtin_amdgcn_fence(__ATOMIC_ACQUIRE, "agent");
            xb_add(&bar[XB_XGEN(b.x)], 1u);
            asm volatile("s_waitcnt vmcnt(0)" ::: "memory");
        } else {
            XB_SPIN(xb_ld(&bar[XB_XGEN(b.x)]) == gen, bar);
            __builtin_amdgcn_fence(__ATOMIC_ACQUIRE, "agent");
            asm volatile("s_waitcnt vmcnt(0)" ::: "memory");
        }
    }
    __syncthreads();
}

struct Frame {
    LAS unsigned char* lds;
    volatile LAS unsigned* MISC;
    gu32* ctl;
    int tid, lane, wave;
    int vcu, G;
    const float *x, *norm_pre, *w_in, *rel_bias, *sinks, *lb_logits, *hgrn_norm, *w_a, *w_h, *w_out, *norm_post;
    float* out;
    unsigned char* ws;
};
__device__ __forceinline__ float wave_sum(float v) {
#pragma unroll
    for (int o = 1; o < 64; o <<= 1) v += __shfl_xor(v, o);
    return v;
}

__device__ __forceinline__ void p0_transpose_item(const float* W, int K, int N, bf16* WT, int ldw, int koff, LAS float* scr, int item, int lane) {
    const int nblk = N / 32, kb = item / nblk, nb = item % nblk, k0 = 64 * kb, n0 = 32 * nb;
#pragma unroll 8
    for (int i = 0; i < 32; ++i) { const int kk = 2 * i + (lane >> 5); scr[kk * 33 + (lane & 31)] = W[(size_t)(k0 + kk) * N + n0 + (lane & 31)]; }
    LDS_WAIT(); asm volatile("" ::: "memory");
    const int c = lane & 7;
#pragma unroll
    for (int j = 0; j < 4; ++j) { const int n = (lane >> 3) + 8 * j; const LAS float* s = scr + (8 * c) * 33 + n;
        v4u o; o.x = pk2(s[0 * 33], s[1 * 33]); o.y = pk2(s[2 * 33], s[3 * 33]); o.z = pk2(s[4 * 33], s[5 * 33]); o.w = pk2(s[6 * 33], s[7 * 33]);
        *(GAS v4u*)(WT + (size_t)(n0 + n) * ldw + koff + k0 + 8 * c) = o; }
    LDS_WAIT(); asm volatile("" ::: "memory");
}
__device__ __forceinline__ void rms_row_to_bf16(int lane, const float* xrow, const float* gain, bf16* orow) {
    const GAS f32x4* xr = (const GAS f32x4*)xrow + lane;
    const GAS f32x4* gr = (const GAS f32x4*)gain + lane;
    f32x4 v[8]; float s = 0.f;
#pragma unroll
    for (int j = 0; j < 8; ++j) { v[j] = xr[64 * j]; s += (v[j].x * v[j].x + v[j].y * v[j].y) + (v[j].z * v[j].z + v[j].w * v[j].w); }
    const float rstd = 1.f / sqrtf(wave_sum(s) * (1.f / D) + NORM_EPS);
    GAS unsigned long long* o8 = (GAS unsigned long long*)orow + lane;
#pragma unroll
    for (int j = 0; j < 8; ++j) { const f32x4 g = gr[64 * j];
        o8[64 * j] = (unsigned long long)pk2(v[j].x * rstd * g.x, v[j].y * rstd * g.y) | ((unsigned long long)pk2(v[j].z * rstd * g.z, v[j].w * rstd * g.w) << 32); }
}
__device__ __forceinline__ int t5_bucket(int d) {
    if (d < 16) return d;
    int b = 16 + (int)(logf((float)d * (1.f / 16.f)) * (16.f / 2.0794415416798357f));
    return b < 31 ? b : 31;
}
__device__ __forceinline__ void p0_prologue(Frame& F) {
    LAS float* scr = (LAS float*)(F.lds + RING_OFF + F.wave * 16384);
    const int gw = F.vcu * NWAVES + F.wave, NGW = F.G * NWAVES;
    constexpr int I_IN = (D / 64) * (NIN / 32), I_A = (AW / 64) * (D / 32), I_H = (HW / 64) * (D / 32), I_O = (D / 64) * (D / 32);
    constexpr int NITEMS = I_IN + I_A + I_H + I_O;
    bf16* WIN = (bf16*)(F.ws + WS_WIN); bf16* W2 = (bf16*)(F.ws + WS_W2); bf16* WO = (bf16*)(F.ws + WS_WO);
    for (int it = gw; it < NITEMS; it += NGW) {
        int r = it;
        if (r < I_IN) { p0_transpose_item(F.w_in, D, NIN, WIN, D, 0, scr, r, F.lane); continue; } r -= I_IN;
        if (r < I_A) { p0_transpose_item(F.w_a, AW, D, W2, 2048, 0, scr, r, F.lane); continue; } r -= I_A;
        if (r < I_H) { p0_transpose_item(F.w_h, HW, D, W2, 2048, 1024, scr, r, F.lane); continue; } r -= I_H;
        p0_transpose_item(F.w_out, D, D, WO, D, 0, scr, r, F.lane);
    }
    bf16* H = (bf16*)(F.ws + WS_H);
    for (int m = gw; m < M; m += NGW) rms_row_to_bf16(F.lane, F.x + (size_t)m * D, F.norm_pre, H + (size_t)m * D);
    if (blockIdx.x == 0) {
        float* bt = (float*)(F.ws + WS_BIAS); float* lb = (float*)(F.ws + WS_LB);
        for (int i = F.tid; i < 16 * 128; i += NWAVES * 64) { const int h = i >> 7, d = i & 127; bt[i] = F.rel_bias[t5_bucket(d) * 16 + h] * LOG2E; }
        for (int i = F.tid; i < 1024; i += NWAVES * 64) { const float l0 = F.lb_logits[i], l1 = F.lb_logits[1024 + i]; lb[i] = 1.f / (1.f + expf(l1 - l0)); }
    }
}

template <int MODE> __device__ __forceinline__ float proj_act(float x, float lb) {
    if (MODE == 1) return x * fsigmoid(x);
    if (MODE == 2) return fsigmoid(x);
    if (MODE == 3) return __logf(lb + (1.f - lb) * fsigmoid(x));
    return x;
}
struct EpiProj {
    static constexpr bool PERM = true;
    unsigned char* ws;
    template <int MODE> __device__ __forceinline__ void store(pg8::f32x4 (&acc)[2][2][4][2], bf16* base, int ldc, int row0, int col0, float scale, const float* lbp) const {
        using pg8::f32x4; using pg8::u32x4;
        f32x4 lbv[2][2];
#pragma unroll
        for (int bj = 0; bj < 2; ++bj)
#pragma unroll
            for (int n = 0; n < 2; ++n) lbv[bj][n] = (MODE == 3) ? *(const f32x4*)(lbp + col0 + bj * 128 + 4 * n) : (f32x4){0.f, 0.f, 0.f, 0.f};
#pragma unroll
        for (int ai = 0; ai < 2; ++ai)
#pragma unroll
            for (int m = 0; m < 4; ++m) { bf16* rowp = base + (size_t)(row0 + ai * 128 + m * 16) * ldc + col0;
#pragma unroll
                for (int bj = 0; bj < 2; ++bj) { f32x4 v0 = acc[ai][bj][m][0], v1 = acc[ai][bj][m][1];
#pragma unroll
                    for (int j = 0; j < 4; ++j) { v0[j] = proj_act<MODE>(v0[j], lbv[bj][0][j]) * scale; v1[j] = proj_act<MODE>(v1[j], lbv[bj][1][j]) * scale; }
                    u32x4 w; w.x = pg8::cvt_pk_bf16(v0[0], v0[1]); w.y = pg8::cvt_pk_bf16(v0[2], v0[3]); w.z = pg8::cvt_pk_bf16(v1[0], v1[1]); w.w = pg8::cvt_pk_bf16(v1[2], v1[3]);
                    *(u32x4*)(rowp + bj * 128) = w; } }
    }
    __device__ __forceinline__ void operator()(pg8::f32x4 (&acc)[2][2][4][2], const pg8::Unit& u, int wr, int wc, int fr, int fq) const {
        const int pn = u.pn, row0 = u.pm * 256 + wr * 64 + fr, cw = wc * 32 + 8 * fq;
        const float* lbp = (const float*)(ws + WS_LB);
        if (pn < 4)       store<0>(acc, (bf16*)(ws + WS_Q), 1024, row0, (pn - 0) * 256 + cw, QSCALE, lbp);
        else if (pn == 4) store<0>(acc, (bf16*)(ws + WS_K), 256, row0, cw, 1.f, lbp);
        else if (pn == 5) store<0>(acc, (bf16*)(ws + WS_V), 256, row0, cw, 1.f, lbp);
        else if (pn < 10) store<1>(acc, (bf16*)(ws + WS_AG), 1024, row0, (pn - 6) * 256 + cw, 1.f, lbp);
        else if (pn < 14) store<1>(acc, (bf16*)(ws + WS_HQ), 1024, row0, (pn - 10) * 256 + cw, 1.f, lbp);
        else if (pn < 18) store<3>(acc, (bf16*)(ws + WS_LF), 1024, row0, (pn - 14) * 256 + cw, 1.f, lbp);
        else if (pn < 22) store<0>(acc, (bf16*)(ws + WS_HI), 1024, row0, (pn - 18) * 256 + cw, 1.f, lbp);
        else if (pn < 26) store<1>(acc, (bf16*)(ws + WS_HG), 1024, row0, (pn - 22) * 256 + cw, 1.f, lbp);
        else if (pn < 34) store<2>(acc, (bf16*)(ws + WS_SA), 2048, row0, (pn - 26) * 256 + cw, 1.f, lbp);
        else              store<2>(acc, (bf16*)(ws + WS_SH), 2048, row0, (pn - 34) * 256 + cw, 1.f, lbp);
    }
};

struct EpiBf16Plain {
    static constexpr bool PERM = true;
    bf16* O; int ldc;
    __device__ __forceinline__ void operator()(pg8::f32x4 (&acc)[2][2][4][2], const pg8::Unit& u, int wr, int wc, int fr, int fq) const {
        using pg8::f32x4; using pg8::u32x4;
        const int row0 = u.pm * 256 + wr * 64 + fr, col0 = u.pn * 256 + wc * 32 + 8 * fq;
#pragma unroll
        for (int ai = 0; ai < 2; ++ai)
#pragma unroll
            for (int m = 0; m < 4; ++m) { bf16* rowp = O + (size_t)(row0 + ai * 128 + m * 16) * ldc + col0;
#pragma unroll
                for (int bj = 0; bj < 2; ++bj) { const f32x4 v0 = acc[ai][bj][m][0], v1 = acc[ai][bj][m][1];
                    u32x4 w; w.x = pg8::cvt_pk_bf16(v0[0], v0[1]); w.y = pg8::cvt_pk_bf16(v0[2], v0[3]); w.z = pg8::cvt_pk_bf16(v1[0], v1[1]); w.w = pg8::cvt_pk_bf16(v1[2], v1[3]);
                    *(u32x4*)(rowp + bj * 128) = w; } }
    }
};
struct EpiMerge {
    static constexpr bool PERM = true;
    unsigned char* ws;
    __device__ __forceinline__ void operator()(pg8::f32x4 (&acc)[2][2][4][2], const pg8::Unit& u, int wr, int wc, int fr, int fq) const {
        using pg8::f32x4; using pg8::u32x4;
        const int row0 = u.pm * 256 + wr * 64 + fr, col0 = u.pn * 256 + wc * 32 + 8 * fq;
        const bf16* SA = (const bf16*)(ws + WS_SA); const bf16* SH = (const bf16*)(ws + WS_SH); bf16* MG = (bf16*)(ws + WS_MERGED);
#pragma unroll
        for (int ai = 0; ai < 2; ++ai)
#pragma unroll
            for (int m = 0; m < 4; ++m) { const size_t ro = (size_t)(row0 + ai * 128 + m * 16) * 2048 + col0;
#pragma unroll
                for (int bj = 0; bj < 2; ++bj) {
                    const u32x4 h = *(const u32x4*)(SH + ro + bj * 128);
                    const float h0 = bflo(h.x), h1 = bfhi(h.x), h2 = bflo(h.y), h3 = bfhi(h.y), h4 = bflo(h.z), h5 = bfhi(h.z), h6 = bflo(h.w), h7 = bfhi(h.w);
                    f32x4& v0 = acc[ai][bj][m][0]; f32x4& v1 = acc[ai][bj][m][1];
                    if (u.br == 0) {
                        const u32x4 a = *(const u32x4*)(SA + ro + bj * 128);
                        v0[0] *= bflo(a.x) * __builtin_amdgcn_rcpf(h0); v0[1] *= bfhi(a.x) * __builtin_amdgcn_rcpf(h1); v0[2] *= bflo(a.y) * __builtin_amdgcn_rcpf(h2); v0[3] *= bfhi(a.y) * __builtin_amdgcn_rcpf(h3);
                        v1[0] *= bflo(a.z) * __builtin_amdgcn_rcpf(h4); v1[1] *= bfhi(a.z) * __builtin_amdgcn_rcpf(h5); v1[2] *= bflo(a.w) * __builtin_amdgcn_rcpf(h6); v1[3] *= bfhi(a.w) * __builtin_amdgcn_rcpf(h7);
                    } else {
                        u32x4 w; w.x = pg8::cvt_pk_bf16(v0[0] * h0, v0[1] * h1); w.y = pg8::cvt_pk_bf16(v0[2] * h2, v0[3] * h3);
                        w.z = pg8::cvt_pk_bf16(v1[0] * h4, v1[1] * h5); w.w = pg8::cvt_pk_bf16(v1[2] * h6, v1[3] * h7);
                        *(u32x4*)(MG + ro + bj * 128) = w;
                    } } }
    }
};

__device__ __forceinline__ void attn_naive(Frame& F) {
    const bf16* Q = (const bf16*)(F.ws + WS_Q); const bf16* Kb = (const bf16*)(F.ws + WS_K); const bf16* Vb = (const bf16*)(F.ws + WS_V);
    const bf16* AG = (const bf16*)(F.ws + WS_AG); bf16* Y = (bf16*)(F.ws + WS_Y12);
    const float* bt = (const float*)(F.ws + WS_BIAS);
    const int nth = F.G * NWAVES * 64;
    for (int item = blockIdx.x * (NWAVES * 64) + F.tid; item < M * 16; item += nth) {
        const int tok = item >> 4, h = item & 15, kvh = h >> 2, t = tok & (SEQ - 1);
        float q[64], o[64];
        { const v4u* qp = (const v4u*)(Q + (size_t)tok * 1024 + h * 64);
#pragma unroll
          for (int c = 0; c < 8; ++c) { const v4u w = qp[c]; q[8 * c + 0] = bflo(w.x); q[8 * c + 1] = bfhi(w.x); q[8 * c + 2] = bflo(w.y); q[8 * c + 3] = bfhi(w.y); q[8 * c + 4] = bflo(w.z); q[8 * c + 5] = bfhi(w.z); q[8 * c + 6] = bflo(w.w); q[8 * c + 7] = bfhi(w.w); } }
#pragma unroll
        for (int d = 0; d < 64; ++d) o[d] = 0.f;
        float mx = F.sinks[h] * LOG2E, l = 1.f;
        const int nk = t < 127 ? t : 127;
        for (int dist = 0; dist <= nk; ++dist) {
            const size_t s = (size_t)(tok - dist);
            const v4u* kp = (const v4u*)(Kb + s * 256 + kvh * 64);
            float sc = 0.f;
#pragma unroll
            for (int c = 0; c < 8; ++c) { const v4u w = kp[c];
                sc += q[8 * c + 0] * bflo(w.x) + q[8 * c + 1] * bfhi(w.x) + q[8 * c + 2] * bflo(w.y) + q[8 * c + 3] * bfhi(w.y) + q[8 * c + 4] * bflo(w.z) + q[8 * c + 5] * bfhi(w.z) + q[8 * c + 6] * bflo(w.w) + q[8 * c + 7] * bfhi(w.w); }
            sc += bt[h * 128 + dist];
            const float mn = fmaxf(mx, sc), a = exp2f(mx - mn), p = exp2f(sc - mn);
            l = l * a + p; mx = mn;
            const v4u* vp = (const v4u*)(Vb + s * 256 + kvh * 64);
#pragma unroll
            for (int c = 0; c < 8; ++c) { const v4u w = vp[c];
                o[8 * c + 0] = o[8 * c + 0] * a + p * bflo(w.x); o[8 * c + 1] = o[8 * c + 1] * a + p * bfhi(w.x); o[8 * c + 2] = o[8 * c + 2] * a + p * bflo(w.y); o[8 * c + 3] = o[8 * c + 3] * a + p * bfhi(w.y);
                o[8 * c + 4] = o[8 * c + 4] * a + p * bflo(w.z); o[8 * c + 5] = o[8 * c + 5] * a + p * bfhi(w.z); o[8 * c + 6] = o[8 * c + 6] * a + p * bflo(w.w); o[8 * c + 7] = o[8 * c + 7] * a + p * bfhi(w.w); }
        }
        const float inv = 1.f / l;
        const v4u* gp = (const v4u*)(AG + (size_t)tok * 1024 + h * 64);
        v4u* yp = (v4u*)(Y + (size_t)tok * 2048 + h * 64);
#pragma unroll
        for (int c = 0; c < 8; ++c) { const v4u g = gp[c]; v4u w;
            w.x = pk2(o[8 * c + 0] * inv * bflo(g.x), o[8 * c + 1] * inv * bfhi(g.x)); w.y = pk2(o[8 * c + 2] * inv * bflo(g.y), o[8 * c + 3] * inv * bfhi(g.y));
            w.z = pk2(o[8 * c + 4] * inv * bflo(g.z), o[8 * c + 5] * inv * bfhi(g.z)); w.w = pk2(o[8 * c + 6] * inv * bflo(g.w), o[8 * c + 7] * inv * bfhi(g.w));
            yp[c] = w; }
    }
}


namespace att {
typedef short bf16x8 __attribute__((ext_vector_type(8)));
typedef short s16x4 __attribute__((ext_vector_type(4)));
typedef float f32x16 __attribute__((ext_vector_type(16)));
constexpr int L_K = 0, L_VT = 32768, VROWB = 520, L_BIAS = L_VT + 64 * VROWB, L_END = L_BIAS + 2048;
constexpr int NUNITS = BATCH * 16 * 4;
#define ATT_MFMA(a, b, c) __builtin_amdgcn_mfma_f32_32x32x16_bf16((a), (b), (c), 0, 0, 0)
__device__ __forceinline__ void decode(int unit, int& b, int& nb, int& kvh) { b = unit >> 6; nb = (unit >> 2) & 15; kvh = unit & 3; }
__device__ __forceinline__ void load_regs(Frame& F, int unit, v4u (&kr)[4], v4u (&vr)[4], float& bias) {
    int b, nb, kvh; decode(unit, b, nb, kvh);
    const bf16* Kb = (const bf16*)(F.ws + WS_K); const bf16* Vb = (const bf16*)(F.ws + WS_V);
    const int tok0 = b * SEQ + nb * 128;
#pragma unroll
    for (int i = 0; i < 4; ++i) { const int p = F.tid + 512 * i, key = p >> 3, chunk = p & 7; int row = tok0 - 128 + key; if (nb == 0 && key < 128) row = tok0;
        kr[i] = *(const v4u*)(Kb + (size_t)row * 256 + kvh * 64 + chunk * 8); }
#pragma unroll
    for (int i = 0; i < 2; ++i) { const int pp = F.tid + 512 * i, kp = pp & 127, chunk = pp >> 7; int row = tok0 - 128 + 2 * kp, row1 = row + 1; if (nb == 0 && kp < 64) { row = tok0; row1 = tok0; }
        vr[2 * i] = *(const v4u*)(Vb + (size_t)row * 256 + kvh * 64 + chunk * 8); vr[2 * i + 1] = *(const v4u*)(Vb + (size_t)row1 * 256 + kvh * 64 + chunk * 8); }
    bias = ((const float*)(F.ws + WS_BIAS))[(kvh * 4 + (F.tid >> 7)) * 128 + (F.tid & 127)];
}
__device__ __forceinline__ void write_lds(Frame& F, const v4u (&kr)[4], const v4u (&vr)[4], float bias) {
#pragma unroll
    for (int i = 0; i < 4; ++i) { const int p = F.tid + 512 * i, key = p >> 3, chunk = p & 7;
        *(LAS v4u*)(F.lds + L_K + key * 128 + ((chunk ^ ((key >> 1) & 7)) << 4)) = kr[i]; }
#pragma unroll
    for (int i = 0; i < 2; ++i) { const int pp = F.tid + 512 * i, kp = pp & 127, chunk = pp >> 7; const v4u a = vr[2 * i], c = vr[2 * i + 1];
        LAS unsigned char* base = F.lds + L_VT + (chunk * 8) * VROWB + kp * 4;
        *(LAS unsigned*)(base + 0 * VROWB) = (a.x & 0xffffu) | (c.x << 16);  *(LAS unsigned*)(base + 1 * VROWB) = (a.x >> 16) | (c.x & 0xffff0000u);
        *(LAS unsigned*)(base + 2 * VROWB) = (a.y & 0xffffu) | (c.y << 16);  *(LAS unsigned*)(base + 3 * VROWB) = (a.y >> 16) | (c.y & 0xffff0000u);
        *(LAS unsigned*)(base + 4 * VROWB) = (a.z & 0xffffu) | (c.z << 16);  *(LAS unsigned*)(base + 5 * VROWB) = (a.z >> 16) | (c.z & 0xffff0000u);
        *(LAS unsigned*)(base + 6 * VROWB) = (a.w & 0xffffu) | (c.w << 16);  *(LAS unsigned*)(base + 7 * VROWB) = (a.w >> 16) | (c.w & 0xffff0000u); }
    *(LAS float*)(F.lds + L_BIAS + F.tid * 4) = bias;
}
__device__ __forceinline__ void compute(Frame& F, int unit) {
    int b, nb, kvh; decode(unit, b, nb, kvh);
    const bf16* Q = (const bf16*)(F.ws + WS_Q); const bf16* AG = (const bf16*)(F.ws + WS_AG); bf16* Y = (bf16*)(F.ws + WS_Y12);
    const int g = F.wave >> 1, qh = F.wave & 1, r = F.lane & 31, h = F.lane >> 5, hq = kvh * 4 + g;
    const int tok0 = b * SEQ + nb * 128;
    const float sinkv = F.sinks[hq] * LOG2E;
    const LAS float* tab = (const LAS float*)(F.lds + L_BIAS) + g * 128;
    const int dl = r - 4 * h;
    for (int sb = 0; sb < 2; ++sb) {
        const int j = 2 * qh + sb; const size_t tok = (size_t)(tok0 + 32 * j + r);
        bf16x8 Qf[4];
#pragma unroll
        for (int s = 0; s < 4; ++s) Qf[s] = *(const bf16x8*)(Q + tok * 1024 + hq * 64 + 16 * s + 8 * h);
        f32x16 S[5];
#pragma unroll
        for (int c = 0; c < 5; ++c) { const int key = 32 * (j + c) + r, sw = (key >> 1) & 7; const LAS unsigned char* kp = F.lds + L_K + key * 128;
            f32x16 acc;
#pragma unroll
            for (int i = 0; i < 16; ++i) acc[i] = 0.f;
#pragma unroll
            for (int s = 0; s < 4; ++s) { const bf16x8 a = *(const LAS bf16x8*)(kp + (((2 * s + h) ^ sw) << 4)); acc = ATT_MFMA(a, Qf[s], acc); }
            S[c] = acc; }
        float m = sinkv;
#pragma unroll
        for (int c = 0; c < 5; ++c) { const bool tile_ok = !(nb == 0 && (j + c) < 4);
#pragma unroll
            for (int i = 0; i < 16; ++i) { const int kk0 = (i & 3) + 8 * (i >> 2); const int dist = dl + 128 - 32 * c - kk0;
                bool ok = tile_ok; if (c == 0) ok = ok && (dist <= 127); if (c == 4) ok = ok && (dist >= 0);
                const float sv = ok ? S[c][i] + tab[dist & 127] : -INFINITY; S[c][i] = sv; m = fmaxf(m, sv); } }
        m = fmaxf(m, __shfl_xor(m, 32));
        float ls = 0.f;
#pragma unroll
        for (int c = 0; c < 5; ++c)
#pragma unroll
            for (int i = 0; i < 16; ++i) { const float p = __builtin_amdgcn_exp2f(S[c][i] - m); S[c][i] = p; ls += p; }
        ls += __shfl_xor(ls, 32);
        const float inv = 1.f / (ls + __builtin_amdgcn_exp2f(sinkv - m));
        f32x16 O0, O1;
#pragma unroll
        for (int i = 0; i < 16; ++i) { O0[i] = 0.f; O1[i] = 0.f; }
#pragma unroll
        for (int c = 0; c < 5; ++c)
#pragma unroll
            for (int sp = 0; sp < 2; ++sp) {
                v4u pw; pw.x = pg8::cvt_pk_bf16(S[c][8 * sp + 0] * inv, S[c][8 * sp + 1] * inv); pw.y = pg8::cvt_pk_bf16(S[c][8 * sp + 2] * inv, S[c][8 * sp + 3] * inv);
                pw.z = pg8::cvt_pk_bf16(S[c][8 * sp + 4] * inv, S[c][8 * sp + 5] * inv); pw.w = pg8::cvt_pk_bf16(S[c][8 * sp + 6] * inv, S[c][8 * sp + 7] * inv);
                const bf16x8 Pf = __builtin_bit_cast(bf16x8, pw);
                const int keybase = 32 * (j + c) + 16 * sp + 4 * h;
                { const LAS unsigned char* vp = F.lds + L_VT + r * VROWB + keybase * 2; const s16x4 lo = *(const LAS s16x4*)vp, hi = *(const LAS s16x4*)(vp + 16);
                  const bf16x8 Vf = {lo[0], lo[1], lo[2], lo[3], hi[0], hi[1], hi[2], hi[3]}; O0 = ATT_MFMA(Vf, Pf, O0); }
                { const LAS unsigned char* vp = F.lds + L_VT + (32 + r) * VROWB + keybase * 2; const s16x4 lo = *(const LAS s16x4*)vp, hi = *(const LAS s16x4*)(vp + 16);
                  const bf16x8 Vf = {lo[0], lo[1], lo[2], lo[3], hi[0], hi[1], hi[2], hi[3]}; O1 = ATT_MFMA(Vf, Pf, O1); }
            }
        const bf16* agp = AG + tok * 1024 + hq * 64 + 4 * h; bf16* yp = Y + tok * 2048 + hq * 64 + 4 * h;
#pragma unroll
        for (int g4 = 0; g4 < 4; ++g4) {
            { const uint2 a = *(const uint2*)(agp + 8 * g4); uint2 w; w.x = pg8::cvt_pk_bf16(O0[4 * g4 + 0] * bflo(a.x), O0[4 * g4 + 1] * bfhi(a.x)); w.y = pg8::cvt_pk_bf16(O0[4 * g4 + 2] * bflo(a.y), O0[4 * g4 + 3] * bfhi(a.y)); *(uint2*)(yp + 8 * g4) = w; }
            { const uint2 a = *(const uint2*)(agp + 32 + 8 * g4); uint2 w; w.x = pg8::cvt_pk_bf16(O1[4 * g4 + 0] * bflo(a.x), O1[4 * g4 + 1] * bfhi(a.x)); w.y = pg8::cvt_pk_bf16(O1[4 * g4 + 2] * bflo(a.y), O1[4 * g4 + 3] * bfhi(a.y)); *(uint2*)(yp + 32 + 8 * g4) = w; }
        }
    }
}
__device__ __forceinline__ void phase(Frame& F, int first, int stride) {
    if (first >= NUNITS) return;
    v4u kr[4], vr[4]; float bias;
    load_regs(F, first, kr, vr, bias);
    for (int u = first; u < NUNITS; u += stride) {
        write_lds(F, kr, vr, bias);
        __syncthreads();
        if (u + stride < NUNITS) load_regs(F, u + stride, kr, vr, bias);
        compute(F, u);
        __syncthreads();
    }
}
#undef ATT_MFMA
}


namespace hg {
typedef short bf16x8 __attribute__((ext_vector_type(8)));
typedef short s16x4 __attribute__((ext_vector_type(4)));
typedef float f32x16 __attribute__((ext_vector_type(16)));
typedef float f32x2v __attribute__((ext_vector_type(2)));
typedef unsigned u32x2v __attribute__((ext_vector_type(2)));
constexpr int TP = 136;
constexpr int L_QG = 0, L_KN = 16384, L_KDT = 32768, L_VT = L_KDT + 128 * TP, L_ST = L_VT + 128 * TP, L_DEC = L_ST + 32768, L_TOT = L_DEC + 512, L_END = L_TOT + 4096, L_OB = 0;
static_assert(L_END <= RING_BYTES && (L_VT % 16) == 0 && (L_ST % 16) == 0 && (L_DEC % 16) == 0 && (L_TOT % 16) == 0, "hgrn LDS map");
#define HG_MFMA(a, b, c) __builtin_amdgcn_mfma_f32_32x32x16_bf16((a), (b), (c), 0, 0, 0)
struct Pre { unsigned q2[8], lf2[8]; v4u va, vb, hg0, hg1; };
__device__ __forceinline__ void load_chunk(Frame& F, int b, int h, int c, Pre& P) {
    const bf16* HQ = (const bf16*)(F.ws + WS_HQ); const bf16* LF = (const bf16*)(F.ws + WS_LF); const bf16* HI = (const bf16*)(F.ws + WS_HI); const bf16* HG = (const bf16*)(F.ws + WS_HG);
    const size_t tokc = (size_t)b * SEQ + 64 * c;
#pragma unroll
    for (int i = 0; i < 8; ++i) { const size_t o = (tokc + 8 * F.wave + i) * 1024 + h * 128 + 2 * F.lane; P.q2[i] = *(const unsigned*)(HQ + o); P.lf2[i] = *(const unsigned*)(LF + o); }
    { const int sp = F.tid & 31, ch = F.tid >> 5; const size_t o = (tokc + 2 * sp) * 1024 + h * 128 + ch * 8; P.va = *(const v4u*)(HI + o); P.vb = *(const v4u*)(HI + o + 1024); }
    { const int t = F.tid >> 3, ec = F.tid & 7; const size_t o = (tokc + t) * 1024 + h * 128 + 16 * ec; P.hg0 = *(const v4u*)(HG + o); P.hg1 = *(const v4u*)(HG + o + 8); }
}
__device__ __forceinline__ void unit(Frame& F, int u) {
    const int b = u >> 3, h = u & 7;
    const int lane = F.lane, wave = F.wave, r = lane & 31, hh = lane >> 5;
    const int tb = wave >> 2, eb = wave & 3, db = wave >> 1, eb2 = 2 * (wave & 1);
    bf16* Y = (bf16*)(F.ws + WS_Y12);
    for (int i = F.tid; i < 32768 / 16; i += 512) *(LAS v4u*)(F.lds + L_ST + i * 16) = (v4u){0u, 0u, 0u, 0u};
    f32x16 S0, S1;
#pragma unroll
    for (int i = 0; i < 16; ++i) { S0[i] = 0.f; S1[i] = 0.f; }
    Pre P; load_chunk(F, b, h, 0, P);
    for (int c = 0; c < SEQ / 64; ++c) {
        const size_t tokc = (size_t)b * SEQ + 64 * c;
        float pa[8], pb[8]; float ra = 0.f, rb = 0.f;
#pragma unroll
        for (int i = 0; i < 8; ++i) { ra += bflo(P.lf2[i]); rb += bfhi(P.lf2[i]); pa[i] = ra; pb[i] = rb; }
        *(LAS f32x2v*)(F.lds + L_TOT + (wave * 128 + 2 * lane) * 4) = (f32x2v){ra, rb};
        __syncthreads();
        float offa = 0.f, offb = 0.f, gla = 0.f, glb = 0.f;
#pragma unroll
        for (int sgm = 0; sgm < 8; ++sgm) { const f32x2v t2 = *(const LAS f32x2v*)(F.lds + L_TOT + (sgm * 128 + 2 * lane) * 4); if (sgm < wave) { offa += t2.x; offb += t2.y; } gla += t2.x; glb += t2.y; }
        float kda[8], kdb[8];
#pragma unroll
        for (int i = 0; i < 8; ++i) { const int t = 8 * wave + i;
            const float ga = offa + pa[i], gb = offb + pb[i];
            const float ka = 1.f - __expf(bflo(P.lf2[i])), kb = 1.f - __expf(bfhi(P.lf2[i]));
            const float qga = bflo(P.q2[i]) * __expf(ga), qgb = bfhi(P.q2[i]) * __expf(gb);
            const float kna = ka * __expf(-ga), knb = kb * __expf(-gb);
            kda[i] = ka * __expf(gla - ga); kdb[i] = kb * __expf(glb - gb);
            const int off = t * 256 + (((lane >> 2) ^ (t & 15)) << 4) + (lane & 3) * 4;
            *(LAS unsigned*)(F.lds + L_QG + off) = pg8::cvt_pk_bf16(qga, qgb);
            *(LAS unsigned*)(F.lds + L_KN + off) = pg8::cvt_pk_bf16(kna, knb); }
        { LAS unsigned char* ka_p = F.lds + L_KDT + (2 * lane) * TP + 16 * wave; LAS unsigned char* kb_p = ka_p + TP;
          u32x2v w;
          w.x = pg8::cvt_pk_bf16(kda[0], kda[1]); w.y = pg8::cvt_pk_bf16(kda[2], kda[3]); *(LAS u32x2v*)(ka_p) = w;
          w.x = pg8::cvt_pk_bf16(kda[4], kda[5]); w.y = pg8::cvt_pk_bf16(kda[6], kda[7]); *(LAS u32x2v*)(ka_p + 8) = w;
          w.x = pg8::cvt_pk_bf16(kdb[0], kdb[1]); w.y = pg8::cvt_pk_bf16(kdb[2], kdb[3]); *(LAS u32x2v*)(kb_p) = w;
          w.x = pg8::cvt_pk_bf16(kdb[4], kdb[5]); w.y = pg8::cvt_pk_bf16(kdb[6], kdb[7]); *(LAS u32x2v*)(kb_p + 8) = w; }
        if (wave == 0) *(LAS f32x2v*)(F.lds + L_DEC + 2 * lane * 4) = (f32x2v){__expf(gla), __expf(glb)};
        { const int sp = F.tid & 31, ch = F.tid >> 5; const v4u a = P.va, cc = P.vb; LAS unsigned char* base = F.lds + L_VT + (ch * 8) * TP + sp * 4;
          *(LAS unsigned*)(base + 0 * TP) = (a.x & 0xffffu) | (cc.x << 16);  *(LAS unsigned*)(base + 1 * TP) = (a.x >> 16) | (cc.x & 0xffff0000u);
          *(LAS unsigned*)(base + 2 * TP) = (a.y & 0xffffu) | (cc.y << 16);  *(LAS unsigned*)(base + 3 * TP) = (a.y >> 16) | (cc.y & 0xffff0000u);
          *(LAS unsigned*)(base + 4 * TP) = (a.z & 0xffffu) | (cc.z << 16);  *(LAS unsigned*)(base + 5 * TP) = (a.z >> 16) | (cc.z & 0xffff0000u);
          *(LAS unsigned*)(base + 6 * TP) = (a.w & 0xffffu) | (cc.w << 16);  *(LAS unsigned*)(base + 7 * TP) = (a.w >> 16) | (cc.w & 0xffff0000u); }
        const v4u hgw0 = P.hg0, hgw1 = P.hg1;
        __syncthreads();
        if (c + 1 < SEQ / 64) load_chunk(F, b, h, c + 1, P);
        f32x16 O;
#pragma unroll
        for (int i = 0; i < 16; ++i) O[i] = 0.f;
        bf16x8 qf[8];
        { const LAS unsigned char* qrow = F.lds + L_QG + (32 * tb + r) * 256; const LAS unsigned char* srow = F.lds + L_ST + (32 * eb + r) * 256;
#pragma unroll
          for (int ks = 0; ks < 8; ++ks) { const int sw = ((2 * ks + hh) ^ (r & 15)) << 4; qf[ks] = *(const LAS bf16x8*)(qrow + sw); const bf16x8 sf = *(const LAS bf16x8*)(srow + sw); O = HG_MFMA(qf[ks], sf, O); } }
#pragma unroll
        for (int sb = 0; sb < 2; ++sb) {
            if (sb <= tb) {
                f32x16 X;
#pragma unroll
                for (int i = 0; i < 16; ++i) X[i] = 0.f;
                const LAS unsigned char* krow = F.lds + L_KN + (32 * sb + r) * 256;
#pragma unroll
                for (int ks = 0; ks < 8; ++ks) { const bf16x8 kf = *(const LAS bf16x8*)(krow + (((2 * ks + hh) ^ (r & 15)) << 4)); X = HG_MFMA(kf, qf[ks], X); }
                if (sb == tb) {
#pragma unroll
                    for (int i = 0; i < 16; ++i) { const int cr = (i & 3) + 8 * (i >> 2) + 4 * hh; X[i] = (cr <= r) ? X[i] : 0.f; } }
#pragma unroll
                for (int sp = 0; sp < 2; ++sp) {
                    v4u pw; pw.x = pg8::cvt_pk_bf16(X[8 * sp + 0], X[8 * sp + 1]); pw.y = pg8::cvt_pk_bf16(X[8 * sp + 2], X[8 * sp + 3]); pw.z = pg8::cvt_pk_bf16(X[8 * sp + 4], X[8 * sp + 5]); pw.w = pg8::cvt_pk_bf16(X[8 * sp + 6], X[8 * sp + 7]);
                    const LAS unsigned char* vp = F.lds + L_VT + (32 * eb + r) * TP + (32 * sb + 16 * sp + 4 * hh) * 2; const s16x4 lo = *(const LAS s16x4*)vp, hi = *(const LAS s16x4*)(vp + 16);
                    const bf16x8 vf = {lo[0], lo[1], lo[2], lo[3], hi[0], hi[1], hi[2], hi[3]};
                    O = HG_MFMA(__builtin_bit_cast(bf16x8, pw), vf, O); }
            }
        }
#pragma unroll
        for (int g4 = 0; g4 < 4; ++g4) { const f32x4 dv = *(const LAS f32x4*)(F.lds + L_DEC + (32 * db + 8 * g4 + 4 * hh) * 4);
#pragma unroll
            for (int jx = 0; jx < 4; ++jx) { S0[4 * g4 + jx] *= dv[jx]; S1[4 * g4 + jx] *= dv[jx]; } }
#pragma unroll
        for (int ks = 0; ks < 4; ++ks) {
            const LAS unsigned char* kp = F.lds + L_KDT + (32 * db + r) * TP + (16 * ks + 8 * hh) * 2; const s16x4 k0 = *(const LAS s16x4*)kp, k1 = *(const LAS s16x4*)(kp + 8);
            const bf16x8 kf = {k0[0], k0[1], k0[2], k0[3], k1[0], k1[1], k1[2], k1[3]};
            { const LAS unsigned char* vp = F.lds + L_VT + (32 * eb2 + r) * TP + (16 * ks + 8 * hh) * 2; const s16x4 v0 = *(const LAS s16x4*)vp, v1 = *(const LAS s16x4*)(vp + 8);
              const bf16x8 vf = {v0[0], v0[1], v0[2], v0[3], v1[0], v1[1], v1[2], v1[3]}; S0 = HG_MFMA(kf, vf, S0); }
            { const LAS unsigned char* vp = F.lds + L_VT + (32 * (eb2 + 1) + r) * TP + (16 * ks + 8 * hh) * 2; const s16x4 v0 = *(const LAS s16x4*)vp, v1 = *(const LAS s16x4*)(vp + 8);
              const bf16x8 vf = {v0[0], v0[1], v0[2], v0[3], v1[0], v1[1], v1[2], v1[3]}; S1 = HG_MFMA(kf, vf, S1); }
        }
        __syncthreads();
#pragma unroll
        for (int g4 = 0; g4 < 4; ++g4) { const int ch = 4 * db + g4;
            { const int e = 32 * eb2 + r; u32x2v w; w.x = pg8::cvt_pk_bf16(S0[4 * g4 + 0], S0[4 * g4 + 1]); w.y = pg8::cvt_pk_bf16(S0[4 * g4 + 2], S0[4 * g4 + 3]);
              *(LAS u32x2v*)(F.lds + L_ST + e * 256 + ((ch ^ (e & 15)) << 4) + 8 * hh) = w; }
            { const int e = 32 * (eb2 + 1) + r; u32x2v w; w.x = pg8::cvt_pk_bf16(S1[4 * g4 + 0], S1[4 * g4 + 1]); w.y = pg8::cvt_pk_bf16(S1[4 * g4 + 2], S1[4 * g4 + 3]);
              *(LAS u32x2v*)(F.lds + L_ST + e * 256 + ((ch ^ (e & 15)) << 4) + 8 * hh) = w; } }
#pragma unroll
        for (int i = 0; i < 16; ++i) { const int t = 32 * tb + (i & 3) + 8 * (i >> 2) + 4 * hh; *(LAS float*)(F.lds + L_OB + t * 512 + (32 * eb + r) * 4) = O[i]; }
        __syncthreads();
        { const int t = F.tid >> 3, ec = F.tid & 7; const LAS unsigned char* op = F.lds + L_OB + t * 512 + ec * 64;
          const f32x4 o0 = *(const LAS f32x4*)(op), o1 = *(const LAS f32x4*)(op + 16), o2 = *(const LAS f32x4*)(op + 32), o3 = *(const LAS f32x4*)(op + 48);
          float ss = (o0.x * o0.x + o0.y * o0.y) + (o0.z * o0.z + o0.w * o0.w) + (o1.x * o1.x + o1.y * o1.y) + (o1.z * o1.z + o1.w * o1.w) + (o2.x * o2.x + o2.y * o2.y) + (o2.z * o2.z + o2.w * o2.w) + (o3.x * o3.x + o3.y * o3.y) + (o3.z * o3.z + o3.w * o3.w);
          ss += __shfl_xor(ss, 1); ss += __shfl_xor(ss, 2); ss += __shfl_xor(ss, 4);
          const float rstd = 1.f / sqrtf(ss * (1.f / 128.f) + NORM_EPS);
          const float* gp = F.hgrn_norm + h * 128 + 16 * ec; const f32x4 n0 = *(const f32x4*)(gp), n1 = *(const f32x4*)(gp + 4), n2 = *(const f32x4*)(gp + 8), n3 = *(const f32x4*)(gp + 12);
          v4u w0, w1;
          w0.x = pg8::cvt_pk_bf16(o0.x * rstd * n0.x * bflo(hgw0.x), o0.y * rstd * n0.y * bfhi(hgw0.x)); w0.y = pg8::cvt_pk_bf16(o0.z * rstd * n0.z * bflo(hgw0.y), o0.w * rstd * n0.w * bfhi(hgw0.y));
          w0.z = pg8::cvt_pk_bf16(o1.x * rstd * n1.x * bflo(hgw0.z), o1.y * rstd * n1.y * bfhi(hgw0.z)); w0.w = pg8::cvt_pk_bf16(o1.z * rstd * n1.z * bflo(hgw0.w), o1.w * rstd * n1.w * bfhi(hgw0.w));
          w1.x = pg8::cvt_pk_bf16(o2.x * rstd * n2.x * bflo(hgw1.x), o2.y * rstd * n2.y * bfhi(hgw1.x)); w1.y = pg8::cvt_pk_bf16(o2.z * rstd * n2.z * bflo(hgw1.y), o2.w * rstd * n2.w * bfhi(hgw1.y));
          w1.z = pg8::cvt_pk_bf16(o3.x * rstd * n3.x * bflo(hgw1.z), o3.y * rstd * n3.y * bfhi(hgw1.z)); w1.w = pg8::cvt_pk_bf16(o3.z * rstd * n3.z * bflo(hgw1.w), o3.w * rstd * n3.w * bfhi(hgw1.w));
          bf16* yp = Y + (tokc + t) * 2048 + 1024 + h * 128 + 16 * ec; *(v4u*)yp = w0; *(v4u*)(yp + 8) = w1; }
    }
    __syncthreads();
}
#undef HG_MFMA
}

__device__ __forceinline__ void hgrn_naive(Frame& F) {
    const bf16* HQ = (const bf16*)(F.ws + WS_HQ); const bf16* LF = (const bf16*)(F.ws + WS_LF); const bf16* HI = (const bf16*)(F.ws + WS_HI);
    float* OR = (float*)(F.ws + WS_ORAW);
    LAS unsigned char* sQ = F.lds;
    LAS unsigned char* sF = F.lds + 8192;
    LAS unsigned char* sV = F.lds + 16384;
    LAS float* sP = (LAS float*)(F.lds + 32768);
    for (int unit = blockIdx.x; unit < 256; unit += F.G) {
        const int bh = unit >> 1, eh = unit & 1, b = bh >> 3, h = bh & 7;
        float S[16];
#pragma unroll
        for (int i = 0; i < 16; ++i) S[i] = 0.f;
        for (int blk = 0; blk < SEQ / 32; ++blk) {
            const size_t tok0 = (size_t)b * SEQ + blk * 32;
            { const int r = F.tid >> 4, c = F.tid & 15;
              *(LAS v4u*)(sQ + F.tid * 16) = *(const v4u*)(HQ + (tok0 + r) * 1024 + h * 128 + c * 8);
              *(LAS v4u*)(sF + F.tid * 16) = *(const v4u*)(LF + (tok0 + r) * 1024 + h * 128 + c * 8);
              if (F.tid < 256) { const int r2 = F.tid >> 3, c2 = F.tid & 7; *(LAS v4u*)(sV + F.tid * 16) = *(const v4u*)(HI + (tok0 + r2) * 1024 + h * 128 + eh * 64 + c2 * 8); } }
            __syncthreads();
            for (int t = 0; t < 32; ++t) {
                const v4u q0 = *(const LAS v4u*)(sQ + t * 256 + F.wave * 32), q1 = *(const LAS v4u*)(sQ + t * 256 + F.wave * 32 + 16);
                const v4u f0 = *(const LAS v4u*)(sF + t * 256 + F.wave * 32), f1 = *(const LAS v4u*)(sF + t * 256 + F.wave * 32 + 16);
                const unsigned short vb = *(const LAS unsigned short*)(sV + t * 128 + F.lane * 2);
                const float v = __uint_as_float((unsigned)vb << 16);
                const unsigned qw[8] = {q0.x, q0.y, q0.z, q0.w, q1.x, q1.y, q1.z, q1.w};
                const unsigned fw[8] = {f0.x, f0.y, f0.z, f0.w, f1.x, f1.y, f1.z, f1.w};
                float o = 0.f;
#pragma unroll
                for (int j = 0; j < 8; ++j) {
                    { const float f = __expf(bflo(fw[j])), k = 1.f - f; S[2 * j] = f * S[2 * j] + k * v; o += bflo(qw[j]) * S[2 * j]; }
                    { const float f = __expf(bfhi(fw[j])), k = 1.f - f; S[2 * j + 1] = f * S[2 * j + 1] + k * v; o += bfhi(qw[j]) * S[2 * j + 1]; }
                }
                sP[(F.wave * 32 + t) * 64 + F.lane] = o;
            }
            __syncthreads();
#pragma unroll
            for (int r = 0; r < 4; ++r) { const int idx = F.tid + 512 * r, t = idx >> 6, e = idx & 63; float s = 0.f;
#pragma unroll
                for (int w = 0; w < 8; ++w) s += sP[(w * 32 + t) * 64 + e];
                OR[(tok0 + t) * 1024 + h * 128 + eh * 64 + e] = s; }
        }
        __syncthreads();
    }
}
__device__ __forceinline__ void hgrn_norm_gate(Frame& F) {
    const float* OR = (const float*)(F.ws + WS_ORAW); const bf16* HG = (const bf16*)(F.ws + WS_HG); bf16* Y = (bf16*)(F.ws + WS_Y12);
    const int gw = F.vcu * NWAVES + F.wave, NGW = F.G * NWAVES;
    for (int tok = gw; tok < M; tok += NGW) {
        const int c0 = F.lane * 16;
        f32x4 v[4]; float s = 0.f;
#pragma unroll
        for (int j = 0; j < 4; ++j) { v[j] = *(const f32x4*)(OR + (size_t)tok * 1024 + c0 + 4 * j); s += (v[j].x * v[j].x + v[j].y * v[j].y) + (v[j].z * v[j].z + v[j].w * v[j].w); }
        s += __shfl_xor(s, 1); s += __shfl_xor(s, 2); s += __shfl_xor(s, 4);
        const float rstd = 1.f / sqrtf(s * (1.f / 128.f) + NORM_EPS);
        const v4u g0 = *(const v4u*)(HG + (size_t)tok * 1024 + c0), g1 = *(const v4u*)(HG + (size_t)tok * 1024 + c0 + 8);
        const f32x4 n0 = *(const f32x4*)(F.hgrn_norm + c0), n1 = *(const f32x4*)(F.hgrn_norm + c0 + 4), n2 = *(const f32x4*)(F.hgrn_norm + c0 + 8), n3 = *(const f32x4*)(F.hgrn_norm + c0 + 12);
        v4u w0, w1;
        w0.x = pk2(v[0].x * rstd * n0.x * bflo(g0.x), v[0].y * rstd * n0.y * bfhi(g0.x)); w0.y = pk2(v[0].z * rstd * n0.z * bflo(g0.y), v[0].w * rstd * n0.w * bfhi(g0.y));
        w0.z = pk2(v[1].x * rstd * n1.x * bflo(g0.z), v[1].y * rstd * n1.y * bfhi(g0.z)); w0.w = pk2(v[1].z * rstd * n1.z * bflo(g0.w), v[1].w * rstd * n1.w * bfhi(g0.w));
        w1.x = pk2(v[2].x * rstd * n2.x * bflo(g1.x), v[2].y * rstd * n2.y * bfhi(g1.x)); w1.y = pk2(v[2].z * rstd * n2.z * bflo(g1.y), v[2].w * rstd * n2.w * bfhi(g1.y));
        w1.z = pk2(v[3].x * rstd * n3.x * bflo(g1.z), v[3].y * rstd * n3.y * bfhi(g1.z)); w1.w = pk2(v[3].z * rstd * n3.z * bflo(g1.w), v[3].w * rstd * n3.w * bfhi(g1.w));
        *(v4u*)(Y + (size_t)tok * 2048 + 1024 + c0) = w0; *(v4u*)(Y + (size_t)tok * 2048 + 1024 + c0 + 8) = w1;
    }
}
__device__ __forceinline__ void final_norm(Frame& F) {
    const bf16* Yo = (const bf16*)(F.ws + WS_YOUT);
    const int gw = F.vcu * NWAVES + F.wave, NGW = F.G * NWAVES;
    for (int m = gw; m < M; m += NGW) {
        const v4u* yr = (const v4u*)(Yo + (size_t)m * D) + F.lane;
        v4u yv[4]; float s = 0.f;
#pragma unroll
        for (int j = 0; j < 4; ++j) { yv[j] = yr[64 * j];
            const float a0 = bflo(yv[j].x), a1 = bfhi(yv[j].x), a2 = bflo(yv[j].y), a3 = bfhi(yv[j].y), a4 = bflo(yv[j].z), a5 = bfhi(yv[j].z), a6 = bflo(yv[j].w), a7 = bfhi(yv[j].w);
            s += (a0 * a0 + a1 * a1) + (a2 * a2 + a3 * a3) + (a4 * a4 + a5 * a5) + (a6 * a6 + a7 * a7); }
        const float rstd = 1.f / sqrtf(wave_sum(s) * (1.f / D) + NORM_EPS);
#pragma unroll
        for (int j = 0; j < 4; ++j) { const int c0 = 512 * j + 8 * F.lane;
            const f32x4 g0 = *(const f32x4*)(F.norm_post + c0), g1 = *(const f32x4*)(F.norm_post + c0 + 4);
            const f32x4 x0 = *(const f32x4*)(F.x + (size_t)m * D + c0), x1 = *(const f32x4*)(F.x + (size_t)m * D + c0 + 4);
            f32x4 o0, o1;
            o0.x = x0.x + bflo(yv[j].x) * rstd * g0.x; o0.y = x0.y + bfhi(yv[j].x) * rstd * g0.y; o0.z = x0.z + bflo(yv[j].y) * rstd * g0.z; o0.w = x0.w + bfhi(yv[j].y) * rstd * g0.w;
            o1.x = x1.x + bflo(yv[j].z) * rstd * g1.x; o1.y = x1.y + bfhi(yv[j].z) * rstd * g1.y; o1.z = x1.z + bflo(yv[j].w) * rstd * g1.z; o1.w = x1.w + bfhi(yv[j].w) * rstd * g1.w;
            *(f32x4*)(F.out + (size_t)m * D + c0) = o0; *(f32x4*)(F.out + (size_t)m * D + c0 + 4) = o1; }
    }
}

struct Args { const float* in[11]; float* out; unsigned char* ws; int ph_lo, ph_hi, li, pad; };
__global__ void __launch_bounds__(NWAVES * 64, 2) fwd_kernel(Args args) {
    extern __shared__ __attribute__((aligned(16))) unsigned char lds[];
    Frame F;
    F.lds = (LAS unsigned char*)lds;
    F.MISC = (volatile LAS unsigned*)(F.lds + MISC_OFF);
    F.tid = threadIdx.x; F.lane = F.tid & 63; F.wave = __builtin_amdgcn_readfirstlane(F.tid >> 6);
    F.G = gridDim.x; { const int bx = blockIdx.x; F.vcu = (F.G % 8 == 0) ? (bx % 8) * (F.G / 8) + bx / 8 : bx; }
    F.ws = args.ws; F.ctl = (gu32*)(args.ws + WS_CTL);
    F.x = args.in[0]; F.norm_pre = args.in[1]; F.w_in = args.in[2]; F.rel_bias = args.in[3]; F.sinks = args.in[4]; F.lb_logits = args.in[5]; F.hgrn_norm = args.in[6];
    F.w_a = args.in[7]; F.w_h = args.in[8]; F.w_out = args.in[9]; F.norm_post = args.in[10]; F.out = args.out;
    for (int u = F.tid; u < (LDS_BYTES - LDSCTL_OFF) / 4; u += NWAVES * 64) ((LAS unsigned*)(F.lds + LDSCTL_OFF))[u] = 0u;
    __syncthreads();
    XcdBarrier bar; bar.bar = (unsigned*)(F.ctl + CW_BAR); bar.x = 0; bar.st = nullptr;
    if (N_LAUNCHES != PER_PHASE) bar = xcd_barrier_post((unsigned*)(F.ctl + CW_BAR), F.MISC + 8);
#define GRID_BAR(seam) do { if (N_LAUNCHES == PER_PHASE) { if (F.tid == 0) __hip_atomic_store(F.ctl + CW_TMO, 0xBADBA0u | (unsigned)(seam), RLX_AGENT); } else { xcd_barrier(bar); } } while (0)
    const int lo = args.ph_lo, hi = args.ph_hi;
#define IN(k) (lo <= (k) && (k) < hi)
#define BOTH(k) (IN(k) && IN((k) + 1))
    if (IN(0)) { p0_prologue(F); if (BOTH(0)) GRID_BAR(0); }
    if (IN(1)) {
        pg8::Gemm g{(const bf16*)(F.ws + WS_H), (const bf16*)(F.ws + WS_WIN), M, NIN, D, D}; pg8::StaticOrder S; S.init(M, NIN, F.G, (int)blockIdx.x);
        EpiProj E{F.ws};
        pg8::gemm_phase<EpiProj, pg8::StaticOrder>(F.lds + RING_OFF, g, S, E);
        if (BOTH(1)) GRID_BAR(1);
    }
    if (IN(2)) {
        if (F.G == 256) { const int bx = (int)blockIdx.x, grp = (bx >> 3) & 1, idx = (bx >> 4) * 8 + (bx & 7);
            if (grp == 0) hg::unit(F, idx); else att::phase(F, idx, 128); }
        else { att::phase(F, (int)blockIdx.x, F.G); for (int u = (int)blockIdx.x; u < 128; u += F.G) hg::unit(F, u); }
        if (BOTH(2)) GRID_BAR(2); }
    if (IN(3)) {   }
    if (IN(4)) {
        pg8::Gemm g{(const bf16*)(F.ws + WS_Y12), (const bf16*)(F.ws + WS_W2), M, D, 1024, 2048}; pg8::BranchOrder S; S.init(M, D, F.G, (int)blockIdx.x);
        EpiMerge E{F.ws};
        pg8::gemm_phase<EpiMerge, pg8::BranchOrder>(F.lds + RING_OFF, g, S, E);
        if (BOTH(4)) GRID_BAR(4);
    }
    if (IN(5)) {
        pg8::Gemm g{(const bf16*)(F.ws + WS_MERGED), (const bf16*)(F.ws + WS_WO), M, D, D, D}; pg8::StaticOrder S; S.init(M, D, F.G, (int)blockIdx.x);
        EpiBf16Plain E{(bf16*)(F.ws + WS_YOUT), D};
        pg8::gemm_phase<EpiBf16Plain, pg8::StaticOrder>(F.lds + RING_OFF, g, S, E);
        if (BOTH(5)) GRID_BAR(5);
    }
    if (IN(6)) { final_norm(F); }
#undef IN
#undef BOTH
}

extern "C" void kernel_launch(void* const* d_in, const int* in_sizes, int n_in, void* d_out, int out_size, void* d_ws, size_t ws_size, hipStream_t stream) {
    static int grid = 0;
    if (grid == 0) {
        if (n_in != 11 || in_sizes[0] != M * D || out_size != M * D || ws_size < WS_END) { fprintf(stderr, "kernel_launch: unexpected shapes: n_in %d in0 %d out %d ws %zu\n", n_in, n_in > 0 ? in_sizes[0] : -1, out_size, ws_size); grid = -1; return; }
        int dev = 0, cus = 0, per_cu = 0;
        if (hipGetDevice(&dev) != hipSuccess || hipDeviceGetAttribute(&cus, hipDeviceAttributeMultiprocessorCount, dev) != hipSuccess) { grid = -1; return; }
        if (hipFuncSetAttribute((const void*)fwd_kernel, hipFuncAttributeMaxDynamicSharedMemorySize, LDS_BYTES) != hipSuccess) { fprintf(stderr, "kernel_launch: hipFuncSetAttribute failed\n"); grid = -1; return; }
        if (hipOccupancyMaxActiveBlocksPerMultiprocessor(&per_cu, (const void*)fwd_kernel, NWAVES * 64, LDS_BYTES) != hipSuccess || per_cu < 1) { fprintf(stderr, "kernel_launch: occupancy query says %d blocks per CU\n", per_cu); }
        (void)hipGetLastError();
        grid = cus;
    }
    if (grid < 0) return;
    if (hipMemsetAsync((char*)d_ws + WS_CTL, 0, CTL_ZERO_BYTES, stream) != hipSuccess) { fprintf(stderr, "kernel_launch: memset failed\n"); return; }
    Args a{};
    for (int i = 0; i < 11; ++i) a.in[i] = (const float*)d_in[i];
    a.out = (float*)d_out; a.ws = (unsigned char*)d_ws;
    for (int li = 0; li < N_LAUNCHES; ++li) {
        a.ph_lo = (N_LAUNCHES == PER_PHASE) ? li : 0; a.ph_hi = (N_LAUNCHES == PER_PHASE) ? li + 1 : PER_PHASE; a.li = li;
        hipLaunchKernelGGL(fwd_kernel, dim3(grid), dim3(NWAVES * 64), LDS_BYTES, stream, a);
        const hipError_t le = hipPeekAtLastError();
        if (le != hipSuccess) { fprintf(stderr, "kernel_launch: launch %d failed: %s\n", li, hipGetErrorName(le)); break; }
    }
}
```
